# Optimizing an MI355X kernel written in HIP

```python
import jax, jax.numpy as jnp
from jax import lax
import numpy as np

D_MODEL = 1024
BATCH = 4
SEQ = 8192
DEPTH = 4

GRID_W = 64
CTX_LEN = 256
HEAD_DIM = 64
NORM_EPS = 1e-6
NA_HEADS = 8
NA_WIN_ROWS = 8
NA_WIN_COLS = 16
NA_W = NA_HEADS * HEAD_DIM
SW_HEADS = 8
SW_KV_HEADS = 2
SW_WINDOW = 128
SW_BLOCK = 128
SW_QW = SW_HEADS * HEAD_DIM
SW_KVW = SW_KV_HEADS * HEAD_DIM
ROPE_THETA = 10000.0
ROPE_FREQS = HEAD_DIM // 4
CONV_WIDTH = 512
CONV_K = 3
D_FF = -(-8 * D_MODEL // (3 * 256)) * 256
N_BRANCHES = 3
IN_SPLITS = (NA_W, NA_W, NA_W, SW_QW, SW_KVW, SW_KVW, CONV_WIDTH, CONV_WIDTH, CONV_WIDTH, N_BRANCHES * D_MODEL)
N_IN = sum(IN_SPLITS)

kernel_name = "hybrid_dit_natten_swa_shortconv"


def rms_norm(x, g):
    xf = x.astype(jnp.float32)
    y = xf * lax.rsqrt(jnp.mean(xf * xf, axis=-1, keepdims=True) + NORM_EPS)
    return (y * g.astype(jnp.float32)).astype(x.dtype)


def modulate(h, shift, scale):
    return h * (1 + scale) + shift


def split_in(z):
    idx = np.cumsum(IN_SPLITS)[:-1].tolist()
    return jnp.split(z, idx, axis=-1)


def to_heads(t, n_heads):
    b, n, _ = t.shape
    return t.reshape(b, n, n_heads, HEAD_DIM).transpose(0, 2, 1, 3)


def from_heads(o):
    b, h, n, d = o.shape
    return o.transpose(0, 2, 1, 3).reshape(b, n, h * d)


def axial_rope(n_tokens, dtype):
    t = jnp.arange(n_tokens, dtype=jnp.int32)
    row = (t // GRID_W).astype(jnp.float32)
    col = (t % GRID_W).astype(jnp.float32)
    inv = ROPE_THETA ** (-jnp.arange(ROPE_FREQS, dtype=jnp.float32) / ROPE_FREQS)
    ang = jnp.concatenate([row[:, None] * inv, col[:, None] * inv], axis=-1)
    return jnp.cos(ang).astype(dtype), jnp.sin(ang).astype(dtype)


def apply_rope(x, cos, sin):
    x1, x2 = x[..., :HEAD_DIM // 2], x[..., HEAD_DIM // 2:]
    return jnp.concatenate([x1 * cos - x2 * sin, x1 * sin + x2 * cos], axis=-1)


def softmax_sink(s, sink):
    if sink is None:
        return jax.nn.softmax(s, axis=-1)
    m = jnp.maximum(jnp.max(s, axis=-1, keepdims=True), sink)
    e = jnp.exp(s - m)
    return e / (jnp.sum(e, axis=-1, keepdims=True) + jnp.exp(sink - m))


def context_attention(qc, kc, vc, sink):
    b, hq, n, d = qc.shape
    hkv = kc.shape[1]
    rep = hq // hkv
    qg = qc.reshape(b, hkv, rep, n, d)
    s = jnp.einsum('bgrqd,bgkd->bgrqk', qg, kc).astype(jnp.float32) * (HEAD_DIM ** -0.5)
    sink_g = None if sink is None else sink.reshape(hkv, rep)[None, :, :, None, None].astype(jnp.float32)
    p = softmax_sink(s, sink_g).astype(vc.dtype)
    return jnp.einsum('bgrqk,bgkd->bgrqd', p, vc).reshape(b, hq, n, d)


def neighbourhood_attention(q, k, v, kc, vc, rpb, rows):
    b, h, s_len, d = q.shape
    kh = min(NA_WIN_ROWS, rows)
    kw = NA_WIN_COLS
    scale = HEAD_DIM ** -0.5
    qg = q.reshape(b, h, rows, GRID_W, d)
    kg_all = k.reshape(b, h, rows, GRID_W, d)
    vg_all = v.reshape(b, h, rows, GRID_W, d)
    col = jnp.arange(GRID_W)
    col_start = jnp.clip(col - kw // 2, 0, GRID_W - kw)
    col_idx = col_start[:, None] + jnp.arange(kw)[None, :]
    dcol = col_idx - col[:, None] + (NA_WIN_COLS - 1)
    rpb = rpb.astype(jnp.float32)

    def row_block(r):
        r0 = jnp.clip(r - kh // 2, 0, rows - kh)
        qr = lax.dynamic_index_in_dim(qg, r, axis=2, keepdims=False)
        k_rows = lax.dynamic_slice_in_dim(kg_all, r0, kh, axis=2)
        v_rows = lax.dynamic_slice_in_dim(vg_all, r0, kh, axis=2)
        kgat = k_rows[:, :, :, col_idx, :]
        vgat = v_rows[:, :, :, col_idx, :]
        s_nb = jnp.einsum('bhwd,bhiwjd->bhwij', qr, kgat).astype(jnp.float32) * scale
        drow = r0 + jnp.arange(kh) - r + (NA_WIN_ROWS - 1)
        bias = rpb[:, drow[:, None, None], dcol[None, :, :]]
        s_nb = (s_nb + bias.transpose(0, 2, 1, 3)[None]).reshape(b, h, GRID_W, kh * kw)
        s_cx = jnp.einsum('bhwd,bhcd->bhwc', qr, kc).astype(jnp.float32) * scale
        p = jax.nn.softmax(jnp.concatenate([s_nb, s_cx], axis=-1), axis=-1).astype(v.dtype)
        p_nb = p[..., :kh * kw].reshape(b, h, GRID_W, kh, kw)
        p_cx = p[..., kh * kw:]
        return (jnp.einsum('bhwij,bhiwjd->bhwd', p_nb, vgat)
                + jnp.einsum('bhwc,bhcd->bhwd', p_cx, vc))

    out = lax.map(row_block, jnp.arange(rows))
    return out.transpose(1, 2, 0, 3, 4).reshape(b, h, s_len, d)


def sliding_window_gqa(q, k, v, kc, vc, sink):
    b, hq, s_len, d = q.shape
    hkv = k.shape[1]
    rep = hq // hkv
    nb = s_len // SW_BLOCK
    band = 3 * SW_BLOCK
    scale = HEAD_DIM ** -0.5
    qg = q.reshape(b, hkv, rep, s_len, d)
    pad = ((0, 0), (0, 0), (SW_BLOCK, SW_BLOCK), (0, 0))
    kp = jnp.pad(k, pad)
    vp = jnp.pad(v, pad)
    rel = (jnp.arange(band) - SW_BLOCK)[None, :] - jnp.arange(SW_BLOCK)[:, None]
    in_window = jnp.abs(rel) <= SW_WINDOW
    sink_g = sink.reshape(hkv, rep)[None, :, :, None, None].astype(jnp.float32)

    def block(n):
        q0 = n * SW_BLOCK
        qb = lax.dynamic_slice_in_dim(qg, q0, SW_BLOCK, axis=3)
        kb = lax.dynamic_slice_in_dim(kp, q0, band, axis=2)
        vb = lax.dynamic_slice_in_dim(vp, q0, band, axis=2)
        kabs = q0 - SW_BLOCK + jnp.arange(band)
        mask = in_window & ((kabs >= 0) & (kabs < s_len))[None, :]
        s_loc = jnp.einsum('bgrqd,bgkd->bgrqk', qb, kb).astype(jnp.float32) * scale
        s_loc = jnp.where(mask, s_loc, -jnp.inf)
        s_cx = jnp.einsum('bgrqd,bgcd->bgrqc', qb, kc).astype(jnp.float32) * scale
        p = softmax_sink(jnp.concatenate([s_loc, s_cx], axis=-1), sink_g).astype(v.dtype)
        return (jnp.einsum('bgrqk,bgkd->bgrqd', p[..., :band], vb)
                + jnp.einsum('bgrqc,bgcd->bgrqd', p[..., band:], vc))

    out = lax.map(block, jnp.arange(nb))
    return out.transpose(1, 2, 3, 0, 4, 5).reshape(b, hq, s_len, d)


def short_conv_mixer(xin, gate_b, gate_c, conv_w):
    u = gate_c * xin
    y = lax.conv_general_dilated(
        u, conv_w[:, None, :].astype(u.dtype), window_strides=(1,),
        padding=((CONV_K // 2, CONV_K // 2),), dimension_numbers=('NWC', 'WIO', 'NWC'),
        feature_group_count=u.shape[-1])
    return gate_b * y


def merge_branches(a_out, b_out, c_out, z_gate, b_gate_l, w_br_a_l, w_br_b_l, w_br_c_l, w_o_l):
    ga, gb, gc = jnp.split(jax.nn.sigmoid(z_gate + b_gate_l), N_BRANCHES, axis=-1)
    merged = ga * (a_out @ w_br_a_l) + gb * (b_out @ w_br_b_l) + gc * (c_out @ w_br_c_l)
    return merged @ w_o_l


def swiglu(h, w_up, w_down):
    gate, up = jnp.split(h @ w_up, 2, axis=-1)
    return (jax.nn.silu(gate) * up) @ w_down


def setup_inputs(seed: int = 0) -> dict:
    key = jax.random.key(seed)
    ks = jax.random.split(key, 20)
    f32 = jnp.float32

    def nrm(k, shape, scale):
        return jax.random.normal(k, shape, f32) * scale

    return {
        "x": nrm(ks[0], (BATCH, SEQ, D_MODEL), 1.0),
        "c": nrm(ks[1], (BATCH, D_MODEL), 1.0),
        "ctx": nrm(ks[2], (BATCH, CTX_LEN, D_MODEL), 1.0),
        "c_ctx": nrm(ks[3], (D_MODEL,), 1.0),
        "w_ada": nrm(ks[4], (DEPTH, D_MODEL, 6 * D_MODEL), 0.5 * D_MODEL ** -0.5),
        "b_ada": nrm(ks[5], (DEPTH, 6 * D_MODEL), 0.02),
        "norm1_g": 1.0 + nrm(ks[6], (DEPTH, D_MODEL), 0.02),
        "norm2_g": 1.0 + nrm(ks[7], (DEPTH, D_MODEL), 0.02),
        "w_in": nrm(ks[8], (DEPTH, D_MODEL, N_IN), D_MODEL ** -0.5),
        "b_gate": nrm(ks[9], (DEPTH, N_BRANCHES * D_MODEL), 0.02),
        "na_rpb": nrm(ks[10], (DEPTH, NA_HEADS, 2 * NA_WIN_ROWS - 1, 2 * NA_WIN_COLS - 1), 0.1),
        "sw_sink": nrm(ks[11], (DEPTH, SW_HEADS), 1.0),
        "conv_w": nrm(ks[12], (DEPTH, CONV_K, CONV_WIDTH), CONV_K ** -0.5),
        "w_br_a": nrm(ks[13], (DEPTH, NA_W, D_MODEL), NA_W ** -0.5),
        "w_br_b": nrm(ks[14], (DEPTH, SW_QW, D_MODEL), SW_QW ** -0.5),
        "w_br_c": nrm(ks[15], (DEPTH, CONV_WIDTH, D_MODEL), CONV_WIDTH ** -0.5),
        "w_o": nrm(ks[16], (DEPTH, D_MODEL, D_MODEL), D_MODEL ** -0.5),
        "w_ffn_up": nrm(ks[17], (DEPTH, D_MODEL, 2 * D_FF), D_MODEL ** -0.5),
        "w_ffn_down": nrm(ks[18], (DEPTH, D_FF, D_MODEL), D_FF ** -0.5),
        "final_norm_g": 1.0 + nrm(ks[19], (D_MODEL,), 0.02),
    }


def reference(x, c, ctx, c_ctx, w_ada, b_ada, norm1_g, norm2_g, w_in, b_gate, na_rpb, sw_sink,
              conv_w, w_br_a, w_br_b, w_br_c, w_o, w_ffn_up, w_ffn_down, final_norm_g):
    b, s_len, _ = x.shape
    rows = s_len // GRID_W
    cos, sin = axial_rope(s_len, x.dtype)
    silu_c = jax.nn.silu(c)
    silu_cc = jax.nn.silu(c_ctx)
    xc = ctx
    for l in range(DEPTH):
        last = l == DEPTH - 1
        sh1, sc1, g1, sh2, sc2, g2 = jnp.split((silu_c @ w_ada[l] + b_ada[l])[:, None, :], 6, axis=-1)
        csh1, csc1, cg1, csh2, csc2, cg2 = jnp.split(silu_cc @ w_ada[l] + b_ada[l], 6, axis=-1)

        h = modulate(rms_norm(x, norm1_g[l]), sh1, sc1)
        hc = modulate(rms_norm(xc, norm1_g[l]), csh1, csc1)
        qa, ka, va, qb, kb, vb, cx, cgb, cgc, zg = split_in(h @ w_in[l])
        qa_c, ka_c, va_c, qb_c, kb_c, vb_c, cx_c, cgb_c, cgc_c, zg_c = split_in(hc @ w_in[l])
        ka_c = to_heads(ka_c, NA_HEADS)
        va_c = to_heads(va_c, NA_HEADS)
        kb_c = to_heads(kb_c, SW_KV_HEADS)
        vb_c = to_heads(vb_c, SW_KV_HEADS)

        a_out = from_heads(neighbourhood_attention(
            to_heads(qa, NA_HEADS), to_heads(ka, NA_HEADS), to_heads(va, NA_HEADS),
            ka_c, va_c, na_rpb[l], rows))
        b_out = from_heads(sliding_window_gqa(
            apply_rope(to_heads(qb, SW_HEADS), cos, sin),
            apply_rope(to_heads(kb, SW_KV_HEADS), cos, sin),
            to_heads(vb, SW_KV_HEADS), kb_c, vb_c, sw_sink[l]))
        c_out = short_conv_mixer(cx, cgb, cgc, conv_w[l])
        x = x + g1 * merge_branches(a_out, b_out, c_out, zg, b_gate[l], w_br_a[l], w_br_b[l], w_br_c[l], w_o[l])

        if not last:
            a_c = from_heads(context_attention(to_heads(qa_c, NA_HEADS), ka_c, va_c, None))
            b_c = from_heads(context_attention(to_heads(qb_c, SW_HEADS), kb_c, vb_c, sw_sink[l]))
            c_c = short_conv_mixer(cx_c, cgb_c, cgc_c, conv_w[l])
            xc = xc + cg1 * merge_branches(a_c, b_c, c_c, zg_c, b_gate[l], w_br_a[l], w_br_b[l], w_br_c[l], w_o[l])

        h2 = modulate(rms_norm(x, norm2_g[l]), sh2, sc2)
        x = x + g2 * swiglu(h2, w_ffn_up[l], w_ffn_down[l])
        if not last:
            hc2 = modulate(rms_norm(xc, norm2_g[l]), csh2, csc2)
            xc = xc + cg2 * swiglu(hc2, w_ffn_up[l], w_ffn_down[l])

    return rms_norm(x, final_norm_g)
```

```cpp
#include <hip/hip_runtime.h>
#include <cstdio>
#include <cstdint>

#ifndef MK_SINGLE
#define MK_SINGLE 0
#endif

#define GAS __attribute__((address_space(1)))
#define LAS __attribute__((address_space(3)))
typedef unsigned short bf16_t;
typedef short bf16x8 __attribute__((ext_vector_type(8)));
typedef float f32x4 __attribute__((ext_vector_type(4)));
typedef float f32x2 __attribute__((ext_vector_type(2)));
typedef float f32x16 __attribute__((ext_vector_type(16)));
typedef unsigned u32x4 __attribute__((ext_vector_type(4)));
typedef unsigned u32x2 __attribute__((ext_vector_type(2)));

constexpr int D = 1024, NBATCH = 4, SEQ = 8192, DEPTH = 4, CTXL = 256;
constexpr int MLAT = NBATCH * SEQ;
constexpr int MCTX = NBATCH * CTXL;
constexpr int MT = MLAT + MCTX;
constexpr int NPAN = MT / 256;
constexpr int NPAN_LAT = MLAT / 256;
constexpr int NIN = 6912, DFF = 2816;
constexpr float NORM_EPS = 1e-6f;
constexpr float LOG2E = 1.4426950408889634f;
constexpr float C2 = 0.125f * LOG2E;
constexpr float NEGBIG = -30000.0f;

constexpr size_t MiB = 1u << 20;
constexpr size_t WS_CTL = 0, CTL_ZERO_BYTES = 1 * MiB;
constexpr size_t WS_MOD = 1 * MiB;
constexpr size_t WS_COS = 2 * MiB, WS_SIN = 3 * MiB;
constexpr size_t WS_CT = 4 * MiB;
constexpr size_t WS_W = 12 * MiB;
constexpr size_t W_LAYER_ELEMS = 18350080;
constexpr size_t WO_W1 = 0, WO_WBR = 7077888, WO_WO = 8650752, WO_W4 = 9699328, WO_W5 = 15466496;
constexpr size_t WS_H = 152 * MiB;
constexpr size_t WS_XC = 218 * MiB;
constexpr size_t WS_Z = 222 * MiB;
constexpr size_t Z33 = 33 * MiB;
constexpr size_t WS_QA = WS_Z, WS_QB = WS_Z + Z33, WS_CGB = WS_Z + 2 * Z33, WS_KA = WS_Z + 3 * Z33, WS_VAT = WS_Z + 4 * Z33, WS_U = WS_Z + 5 * Z33;
constexpr size_t WS_KB = WS_Z + 6 * Z33, WS_VBT = WS_KB + (size_t)MT * 128 * 2;
constexpr size_t WS_MERGED = WS_KA;
constexpr size_t WS_ACT = WS_Z;
constexpr size_t WS_SCR = 437 * MiB;
constexpr size_t WS_END = 501 * MiB;
static_assert(WS_VBT + (size_t)MT * 128 * 2 <= WS_SCR, "ws map");
static_assert(WS_ACT + (size_t)MT * DFF * 2 <= WS_KB, "act overlay");
static_assert(WS_W + 4 * W_LAYER_ELEMS * 2 <= WS_H, "weights");

constexpr int CW_BAR = 4096;

constexpr int RING_OFF = 0, RING_BYTES = 131072;
constexpr int LDSCTL_OFF = RING_BYTES, MISC_OFF = LDSCTL_OFF + 320;
constexpr int LDS_BYTES = 147456;
constexpr int NWAVES = 8;

__device__ __forceinline__ unsigned cvt_pk_bf16(float lo, float hi) { unsigned r; asm volatile("v_cvt_pk_bf16_f32 %0, %1, %2" : "=v"(r) : "v"(lo), "v"(hi)); return r; }
__device__ __forceinline__ float bf_lo(unsigned w) { return __uint_as_float(w << 16); }
__device__ __forceinline__ float bf_hi(unsigned w) { return __uint_as_float(w & 0xffff0000u); }
__device__ __forceinline__ unsigned short f2bf(float f) { return (unsigned short)(cvt_pk_bf16(f, 0.f) & 0xffffu); }
__device__ __forceinline__ float fast_sigmoid(float x) { return __builtin_amdgcn_rcpf(1.0f + __builtin_amdgcn_exp2f(-x * LOG2E)); }
__device__ __forceinline__ u32x4 pack8(f32x4 a, f32x4 b) { u32x4 w; w.x = cvt_pk_bf16(a[0], a[1]); w.y = cvt_pk_bf16(a[2], a[3]); w.z = cvt_pk_bf16(b[0], b[1]); w.w = cvt_pk_bf16(b[2], b[3]); return w; }
__device__ __forceinline__ void unpack8(u32x4 w, f32x4& a, f32x4& b) { a[0] = bf_lo(w.x); a[1] = bf_hi(w.x); a[2] = bf_lo(w.y); a[3] = bf_hi(w.y); b[0] = bf_lo(w.z); b[1] = bf_hi(w.z); b[2] = bf_lo(w.w); b[3] = bf_hi(w.w); }
__device__ __forceinline__ float wave_sum(float v) {
#pragma unroll
    for (int o = 1; o < 64; o <<= 1) v += __shfl_xor(v, o);
    return v;
}
#define LDS_WAIT() asm volatile("s_waitcnt lgkmcnt(0)" ::: "memory")
__device__ __forceinline__ int opaque_tid() { int t = threadIdx.x; asm volatile("" : "+v"(t)); return t; }
typedef GAS bf16_t* gbf_p; typedef GAS float* gf32_p; typedef const GAS float* gcf32_p; typedef GAS u32x4* gu4_p;
#define OPAQUE_S(p) asm volatile("" : "+s"(p))

#define XB_TMO      128
#define XB_XCNT(j)  (256  + 64 * (j))
#define XB_XSUB(j)  (1280 + 64 * (j))
#define XB_XGEN(j)  (2304 + 64 * (j))
#define XB_TOP      3328
#define XB_TOPGEN   3392
#define XCD_BAR_WORDS 3456
#define XB_SPIN_CAP (1u << 18)
__device__ __forceinline__ unsigned xb_ld(unsigned* p)              { return __hip_atomic_load(p, __ATOMIC_RELAXED, __HIP_MEMORY_SCOPE_AGENT); }
__device__ __forceinline__ unsigned xb_add(unsigned* p, unsigned v) { return __hip_atomic_fetch_add(p, v, __ATOMIC_RELAXED, __HIP_MEMORY_SCOPE_AGENT); }
__device__ __forceinline__ unsigned xb_xcc_id() { return (unsigned)__builtin_amdgcn_s_getreg((3 << 11) | 20) & 0xFu; }
#define XB_SPIN(cond, bar) do { unsigned _sp = 0; while (cond) { __builtin_amdgcn_s_sleep(1); \
    if ((++_sp & 255u) == 0u) { if (xb_ld(&(bar)[XB_TMO])) break; if (_sp > XB_SPIN_CAP) { atomicAdd(&(bar)[XB_TMO], 1u); break; } } } } while (0)
struct XcdBarrier { unsigned* bar; unsigned x; volatile LAS unsigned* st; };
__device__ __forceinline__ XcdBarrier xcd_barrier_post(unsigned* bar, volatile LAS unsigned* st) {
    XcdBarrier b; b.bar = bar; b.x = xb_xcc_id(); b.st = st;
    if (threadIdx.x == 0) (void)xb_add(&bar[XB_XCNT(b.x)], 1u);
    return b;
}
__device__ __forceinline__ void xcd_barrier_complete(unsigned* bar, unsigned x, unsigned& nloc, unsigned& nx) {
    const unsigned G = gridDim.x * gridDim.y * gridDim.z;
    unsigned sum, cnt, mine, sp = 0u;
    for (;;) {
        sum = 0u; cnt = 0u; mine = 0u;
#pragma unroll
        for (unsigned j = 0; j < 16; ++j) { const unsigned c = xb_ld(&bar[XB_XCNT(j)]); sum += c; cnt += (c > 0u) ? 1u : 0u; mine = (j == x) ? c : mine; }
        if (sum == G) break;
        __builtin_amdgcn_s_sleep(1);
        if ((++sp & 255u) == 0u) { if (xb_ld(&bar[XB_TMO])) break; if (sp > XB_SPIN_CAP) { atomicAdd(&bar[XB_TMO], 1u); break; } }
    }
    nloc = mine > 0u ? mine : 1u; nx = cnt > 0u ? cnt : 1u;
}
__device__ __forceinline__ void xcd_barrier(const XcdBarrier& b) {
    asm volatile("s_waitcnt vmcnt(0)" ::: "memory");
    __syncthreads();
    if (threadIdx.x == 0) {
        unsigned* bar = b.bar;
        __builtin_amdgcn_s_waitcnt(0);
        unsigned nloc = b.st[0], nx = b.st[1];
        if (nloc == 0u) { xcd_barrier_complete(bar, b.x, nloc, nx); b.st[0] = nloc; b.st[1] = nx; }
        const unsigned old = xb_add(&bar[XB_XSUB(b.x)], 1u);
        const unsigned gen = old / nloc;
        if (old + 1u == (gen + 1u) * nloc) {
            __builtin_amdgcn_fence(__ATOMIC_RELEASE, "agent");
            asm volatile("s_waitcnt vmcnt(0)" ::: "memory");
            const unsigned og = xb_add(&bar[XB_TOP], 1u);
            const unsigned tg = og / nx;
            if (og + 1u == (tg + 1u) * nx) xb_add(&bar[XB_TOPGEN], 1u);
            else XB_SPIN(xb_ld(&bar[XB_TOPGEN]) == tg, bar);
            __builtin_amdgcn_fence(__ATOMIC_ACQUIRE, "agent");
            xb_add(&bar[XB_XGEN(b.x)], 1u);
            asm volatile("s_waitcnt vmcnt(0)" ::: "memory");
        } else {
            XB_SPIN(xb_ld(&bar[XB_XGEN(b.x)]) == gen, bar);
            __builtin_amdgcn_fence(__ATOMIC_ACQUIRE, "agent");
            asm volatile("s_waitcnt vmcnt(0)" ::: "memory");
        }
    }
    __syncthreads();
}

namespace pg8 {
constexpr int BM = 256, BK = 64, HALF = 128, HTB = HALF * BK * 2, STAGE_BYTES = 8 * HTB, NXCD = 8, WGM = 8;
__host__ __device__ __forceinline__ int lds_byte(int r, int c) { const int st = (r >> 4) * 2 + (c >> 5), rr = r & 15, cc = c & 31, ob = rr * 64 + cc * 2; return st * 1024 + (ob ^ (((ob >> 9) & 1) << 5)); }
__host__ __device__ __forceinline__ void stage_rc(int b, int& R, int& C) { const int st = b / 1024, sb = b % 1024, swz = sb ^ (((sb >> 9) & 1) << 5); R = (st >> 1) * 16 + swz / 64; C = (st & 1) * 32 + (swz % 64) / 2; }
__host__ __device__ __forceinline__ int perm32(int rho) { const int n = rho >> 4, i = rho & 15; return 8 * (i >> 2) + 4 * n + (i & 3); }

struct GUnit { const char* A; const char* B; unsigned lda2, ldb2; int nt; int pm, pn, mode; };

__device__ __forceinline__ bool tile_order(long L, int nM, int nN, int& pm, int& pn) {
    const int nwg = nM * nN; if (L >= nwg) return false;
    int wgid = (int)L; { const int q = nwg / NXCD, r = nwg % NXCD, xcd = wgid % NXCD, off = wgid / NXCD; wgid = (xcd < r ? xcd * (q + 1) : r * (q + 1) + (xcd - r) * q) + off; }
    const int nig = WGM * nN, gid = wgid / nig, fm = gid * WGM, gsz = (nM - fm) < WGM ? (nM - fm) : WGM;
    pm = fm + ((wgid % nig) % gsz); pn = (wgid % nig) / gsz; return true;
}

template <class Epi, class Sched>
__device__ __forceinline__ void gemm_phase(LAS unsigned char* lds, const Sched& S, const Epi& E) {
    const int tid = opaque_tid(), wid = __builtin_amdgcn_readfirstlane(tid >> 6), lane = tid & 63, wr = wid >> 2, wc = wid & 3, fr = lane & 15, fq = lane >> 4;
    unsigned sR[2], sRb[2], sC[2];
#pragma unroll
    for (int i = 0; i < 2; ++i) { int R, C; stage_rc(tid * 16 + i * 8192, R, C); sR[i] = (unsigned)R; sRb[i] = (unsigned)(Epi::PERM ? ((R & ~31) + perm32(R & 31)) : R); sC[i] = (unsigned)C * 2u; }
    const size_t kstep = (size_t)(BK * 2);
    const unsigned ldsw = (unsigned)wid * 1024u;
    const int aoff = lds_byte(wr * 64 + fr, fq * 8), boff = lds_byte(wc * 32 + fr, fq * 8);
#define PG8_SA(b, h) (((b) * 2 + (h)) * HTB)
#define PG8_SB(b, h) ((4 + (b) * 2 + (h)) * HTB)
#define PG8_STAGE(bufoff, gbase, voff) do { _Pragma("unroll") for (int _i = 0; _i < 2; ++_i) \
        __builtin_amdgcn_global_load_lds((const unsigned*)((const char*)(gbase) + (voff)[_i]), (LAS unsigned*)(lds + (bufoff) + ldsw + _i * 8192), 16, 0, 0); } while (0)
#define PG8_LDA(dst, b, h) do { _Pragma("unroll") for (int m = 0; m < 4; ++m) _Pragma("unroll") for (int k = 0; k < 2; ++k) dst[m][k] = *(const LAS bf16x8*)(lds + PG8_SA(b, h) + aoff + m * 2048 + k * 1024); } while (0)
#define PG8_LDB(dst, b, h) do { _Pragma("unroll") for (int n = 0; n < 2; ++n) _Pragma("unroll") for (int k = 0; k < 2; ++k) dst[n][k] = *(const LAS bf16x8*)(lds + PG8_SB(b, h) + boff + n * 2048 + k * 1024); } while (0)
#define PG8_MMA(ai, bj, At, Bt) do { __builtin_amdgcn_s_setprio(1); _Pragma("unroll") for (int m = 0; m < 4; ++m) _Pragma("unroll") for (int n = 0; n < 2; ++n) _Pragma("unroll") for (int k = 0; k < 2; ++k) \
        acc[ai][bj][m][n] = __builtin_amdgcn_mfma_f32_16x16x32_bf16(Bt[n][k], At[m][k], acc[ai][bj][m][n], 0, 0, 0); __builtin_amdgcn_s_setprio(0); } while (0)
#define PG8_WAIT_V(n) asm volatile("s_waitcnt vmcnt(" #n ")" ::: "memory")
#define PG8_WAIT_L(n) asm volatile("s_waitcnt lgkmcnt(" #n ")" ::: "memory")
#define PG8_BAR __builtin_amdgcn_s_barrier()
#define PG8_SCHED __builtin_amdgcn_sched_barrier(0)
#define PG8_VOFF(u, vA, vB) do { _Pragma("unroll") for (int _i = 0; _i < 2; ++_i) { vA[_i] = sR[_i] * (u).lda2 + sC[_i]; vB[_i] = sRb[_i] * (u).ldb2 + sC[_i]; } } while (0)
    GUnit cur, nxt; int ui = 0;
    if (!S.next(0, cur)) return;
    f32x4 acc[2][2][4][2];
#pragma unroll
    for (int a = 0; a < 2; ++a)
#pragma unroll
        for (int b = 0; b < 2; ++b)
#pragma unroll
            for (int m = 0; m < 4; ++m)
#pragma unroll
                for (int n = 0; n < 2; ++n) acc[a][b][m][n] = (f32x4){0.f, 0.f, 0.f, 0.f};
    bf16x8 At[4][2], B0[2][2], B1[2][2];
    unsigned vA[2], vB[2], nvA[2], nvB[2];
    PG8_VOFF(cur, vA, vB);
    const char* cA = cur.A; const char* cB = cur.B;
    size_t hA = (size_t)HALF * cur.lda2, hB = (size_t)HALF * cur.ldb2;
    PG8_STAGE(PG8_SB(0, 0), cB, vB); PG8_STAGE(PG8_SB(0, 1), cB + hB, vB); PG8_STAGE(PG8_SA(0, 0), cA, vA); PG8_STAGE(PG8_SA(0, 1), cA + hA, vA);
    if (wr == 1) PG8_BAR;
    PG8_WAIT_V(2); PG8_BAR;
    PG8_STAGE(PG8_SB(1, 0), cB + kstep, vB); PG8_STAGE(PG8_SA(1, 0), cA + kstep, vA); PG8_STAGE(PG8_SB(1, 1), cB + hB + kstep, vB);
    PG8_WAIT_V(6); PG8_BAR;
    for (;;) {
        const bool has_next = S.next(ui + 1, nxt);
        const char* nA = cA; const char* nB = cB; size_t nhA = hA, nhB = hB;
        nvA[0] = vA[0]; nvA[1] = vA[1]; nvB[0] = vB[0]; nvB[1] = vB[1];
        if (has_next) { nA = nxt.A; nB = nxt.B; nhA = (size_t)HALF * nxt.lda2; nhB = (size_t)HALF * nxt.ldb2; PG8_VOFF(nxt, nvA, nvB); }
        const int nt = cur.nt;
        for (int t = 0; t < nt; t += 2) {
            const bool last = (t == nt - 2);
            const char* a1 = cA + (size_t)(t + 1) * kstep;
            const char* a2 = last ? nA : cA + (size_t)(t + 2) * kstep; const char* b2 = last ? nB : cB + (size_t)(t + 2) * kstep;
            const char* a3 = a2 + kstep; const char* b3 = b2 + kstep;
            unsigned wA[2], wB[2]; wA[0] = last ? nvA[0] : vA[0]; wA[1] = last ? nvA[1] : vA[1]; wB[0] = last ? nvB[0] : vB[0]; wB[1] = last ? nvB[1] : vB[1];
            const size_t hA2 = last ? nhA : hA, hB2 = last ? nhB : hB;
            PG8_LDB(B0, 0, 0); PG8_LDB(B1, 0, 1); PG8_SCHED; PG8_LDA(At, 0, 0); PG8_STAGE(PG8_SA(1, 1), a1 + hA, vA);
            PG8_WAIT_V(8); PG8_WAIT_L(0); PG8_BAR; PG8_MMA(0, 0, At, B0); PG8_MMA(0, 1, At, B1); PG8_BAR; PG8_SCHED;
            PG8_LDA(At, 0, 1); PG8_STAGE(PG8_SB(0, 0), b2, wB); PG8_STAGE(PG8_SB(0, 1), b2 + hB2, wB); PG8_STAGE(PG8_SA(0, 0), a2, wA);
            PG8_WAIT_V(8); PG8_WAIT_L(0); PG8_BAR; PG8_MMA(1, 0, At, B0); PG8_MMA(1, 1, At, B1); PG8_BAR; PG8_SCHED;
            PG8_LDB(B0, 1, 0); PG8_LDB(B1, 1, 1); PG8_SCHED; PG8_LDA(At, 1, 0); PG8_STAGE(PG8_SA(0, 1), a2 + hA2, wA);
            PG8_WAIT_V(8); PG8_WAIT_L(0); PG8_BAR; PG8_MMA(0, 0, At, B0); PG8_MMA(0, 1, At, B1); PG8_BAR; PG8_SCHED;
            PG8_LDA(At, 1, 1); PG8_STAGE(PG8_SB(1, 0), b3, wB); PG8_STAGE(PG8_SB(1, 1), b3 + hB2, wB); PG8_STAGE(PG8_SA(1, 0), a3, wA);
            PG8_WAIT_V(8); PG8_WAIT_L(0); PG8_BAR; PG8_MMA(1, 0, At, B0); PG8_MMA(1, 1, At, B1); PG8_BAR; PG8_SCHED;
        }
        if (wr == 0) PG8_BAR;
        E(acc, cur, wr, wc, fr, fq);
        if (!has_next) break;
#pragma unroll
        for (int a = 0; a < 2; ++a)
#pragma unroll
            for (int b = 0; b < 2; ++b)
#pragma unroll
                for (int m = 0; m < 4; ++m)
#pragma unroll
                    for (int n = 0; n < 2; ++n) acc[a][b][m][n] = (f32x4){0.f, 0.f, 0.f, 0.f};
        cur = nxt; cA = nA; cB = nB; hA = nhA; hB = nhB; vA[0] = nvA[0]; vA[1] = nvA[1]; vB[0] = nvB[0]; vB[1] = nvB[1]; ++ui;
        if (wr == 1) PG8_BAR;
    }
    PG8_WAIT_V(0);
    PG8_BAR;
#undef PG8_SA
#undef PG8_SB
#undef PG8_STAGE
#undef PG8_LDA
#undef PG8_LDB
#undef PG8_MMA
#undef PG8_WAIT_V
#undef PG8_WAIT_L
#undef PG8_BAR
#undef PG8_SCHED
#undef PG8_VOFF
}

struct SimpleSched {
    const char* A; const char* B; unsigned lda2, ldb2; int nt, nM, nN, G, c;
    __device__ __forceinline__ bool next(int i, GUnit& u) const {
        int pm, pn; if (!tile_order((long)i * G + c, nM, nN, pm, pn)) return false;
        u.A = A + (size_t)pm * 256 * lda2; u.B = B + (size_t)pn * 256 * ldb2; u.lda2 = lda2; u.ldb2 = ldb2; u.nt = nt; u.pm = pm; u.pn = pn; u.mode = 0; return true;
    }
};
struct G1Sched {
    const char* H; const char* W1; int nM, G, c;
    __device__ __forceinline__ bool next(int i, GUnit& u) const {
        int pm, pn; if (!tile_order((long)i * G + c, nM, 15, pm, pn)) return false;
        const char* hp = H + (size_t)pm * 256 * 2048;
        if (pn < 13) { u.A = hp; u.B = W1 + (size_t)pn * 256 * 2048; } else { u.A = W1 + (size_t)(3328 + (pn - 13) * 256) * 2048; u.B = hp; }
        u.lda2 = 2048; u.ldb2 = 2048; u.nt = 16; u.pm = pm; u.pn = pn; u.mode = 0; return true;
    }
};
struct G2Sched {
    const char* H; const char* W1; const char* OA; const char* WBR; int nM, G, c;
    __device__ __forceinline__ bool next(int i, GUnit& u) const {
        const int tile = i / 6, sub = i - tile * 6, br = sub >> 1;
        int pm, pn; if (!tile_order((long)tile * G + c, nM, 4, pm, pn)) return false;
        if ((sub & 1) == 0) { u.A = H + (size_t)pm * 256 * 2048; u.B = W1 + (size_t)(3840 + br * 1024 + pn * 256) * 2048; u.lda2 = 2048; u.ldb2 = 2048; u.nt = 16; }
        else { u.A = OA + (size_t)br * Z33 + (size_t)pm * 256 * 1024; u.B = WBR + (size_t)(br * 1024 + pn * 256) * 1024; u.lda2 = 1024; u.ldb2 = 1024; u.nt = 8; }
        u.pm = pm; u.pn = pn; u.mode = sub; return true;
    }
};

struct EpiG1 {
    static constexpr bool PERM = true;
    bf16_t *QA, *KA, *VAT, *QB, *U, *CGB, *KB, *VBT; const float *COS, *SIN;
    __device__ __forceinline__ void operator()(const f32x4 (&acc)[2][2][4][2], const GUnit& u, int wr, int wc, int fr, int fq) const {
        const int pn = u.pn;
        const int row0 = u.pm * 256 + wr * 64 + fr;
        const bool latent = u.pm < NPAN_LAT;
        if (pn < 4 || pn == 10 || pn == 11) {
            bf16_t* base; float sc = 1.f; int colt;
            if (pn < 2) { base = QA; sc = C2; colt = pn * 256; } else if (pn < 4) { base = KA; colt = (pn - 2) * 256; } else { base = CGB; colt = (pn - 10) * 256; }
            OPAQUE_S(base);
            gbf_p lp = (gbf_p)base + (size_t)row0 * 512 + colt + wc * 32 + 8 * fq;
#pragma unroll
            for (int ai = 0; ai < 2; ++ai)
#pragma unroll
                for (int m = 0; m < 4; ++m)
#pragma unroll
                    for (int bj = 0; bj < 2; ++bj) *(GAS u32x4*)(lp + (ai * 128 + m * 16) * 512 + bj * 128) = pack8(acc[ai][bj][m][0] * sc, acc[ai][bj][m][1] * sc);
        } else if (pn < 6 || (pn == 12 && wc < 2)) {
            const bool isq = pn < 6;
            bf16_t* base = isq ? QB : KB; const int ld = isq ? 512 : 128; const int head = isq ? (pn - 4) * 4 + wc : wc; const float sc = isq ? C2 : 1.f;
            const float* cosb = COS; const float* sinb = SIN; OPAQUE_S(base); OPAQUE_S(cosb); OPAQUE_S(sinb);
            gbf_p lp = (gbf_p)base + (size_t)row0 * ld + head * 64 + 8 * fq;
            const int t0 = ((u.pm & 31) * 256 + wr * 64 + fr) * 32 + 8 * fq;
            gcf32_p cl = (gcf32_p)cosb + t0; gcf32_p sl = (gcf32_p)sinb + t0;
#pragma unroll
            for (int ai = 0; ai < 2; ++ai)
#pragma unroll
                for (int m = 0; m < 4; ++m) {
                    f32x4 x1a = acc[ai][0][m][0], x1b = acc[ai][0][m][1], x2a = acc[ai][1][m][0], x2b = acc[ai][1][m][1];
                    f32x4 o1a = x1a, o1b = x1b, o2a = x2a, o2b = x2b;
                    if (latent) { gcf32_p cp = cl + (ai * 128 + m * 16) * 32; gcf32_p sp = sl + (ai * 128 + m * 16) * 32;
                        const f32x4 ca = *(const GAS f32x4*)cp, cb = *(const GAS f32x4*)(cp + 4), sa = *(const GAS f32x4*)sp, sb = *(const GAS f32x4*)(sp + 4);
                        o1a = x1a * ca - x2a * sa; o1b = x1b * cb - x2b * sb; o2a = x1a * sa + x2a * ca; o2b = x1b * sb + x2b * cb; }
                    gbf_p rowp = lp + (size_t)(ai * 128 + m * 16) * ld;
                    *(GAS u32x4*)(rowp) = pack8(o1a * sc, o1b * sc); *(GAS u32x4*)(rowp + 32) = pack8(o2a * sc, o2b * sc); asm volatile("" ::: "memory"); }
        } else if (pn < 10) {
            bf16_t* ub = U; OPAQUE_S(ub);
            gbf_p lp = (gbf_p)ub + (size_t)row0 * 512 + (pn - 6) * 128 + wc * 32 + 8 * fq;
#pragma unroll
            for (int ai = 0; ai < 2; ++ai)
#pragma unroll
                for (int m = 0; m < 4; ++m) *(GAS u32x4*)(lp + (ai * 128 + m * 16) * 512) = pack8(acc[ai][0][m][0] * acc[ai][1][m][0], acc[ai][0][m][1] * acc[ai][1][m][1]);
        } else if (pn == 12) {
            bf16_t* vbt = VBT; OPAQUE_S(vbt);
            gbf_p lp = (gbf_p)vbt + (size_t)((wc - 2) * 32 + 8 * fq) * MT + row0;
#pragma unroll
            for (int ai = 0; ai < 2; ++ai)
#pragma unroll
                for (int m = 0; m < 4; ++m)
#pragma unroll
                    for (int bj = 0; bj < 2; ++bj)
#pragma unroll
                        for (int n = 0; n < 2; ++n)
#pragma unroll
                            for (int e = 0; e < 4; ++e) lp[(size_t)(bj * 64 + 4 * n + e) * MT + ai * 128 + m * 16] = f2bf(acc[ai][bj][m][n][e]);
        } else {
            bf16_t* vat = VAT; OPAQUE_S(vat);
            gbf_p lp = (gbf_p)vat + (size_t)((pn - 13) * 256 + wr * 64 + fr) * MT + u.pm * 256 + wc * 32 + 8 * fq;
#pragma unroll
            for (int ai = 0; ai < 2; ++ai)
#pragma unroll
                for (int m = 0; m < 4; ++m)
#pragma unroll
                    for (int bj = 0; bj < 2; ++bj) *(GAS u32x4*)(lp + (size_t)(ai * 128 + m * 16) * MT + bj * 128) = pack8(acc[ai][bj][m][0], acc[ai][bj][m][1]);
        }
    }
};
struct EpiG2 {
    static constexpr bool PERM = true;
    u32x4* SG; u32x4* ST; bf16_t* MERGED; const float* bgate;
    __device__ __forceinline__ void operator()(const f32x4 (&acc)[2][2][4][2], const GUnit& u, int wr, int wc, int fr, int fq) const {
        const int sub = u.mode, br = sub >> 1, tid = (wr * 4 + wc) * 64 + fq * 16 + fr;
        u32x4* sg = SG; u32x4* st = ST; bf16_t* mg = MERGED; const float* bg = bgate; OPAQUE_S(sg); OPAQUE_S(st); OPAQUE_S(mg); OPAQUE_S(bg);
        gu4_p sgl = (gu4_p)sg + tid; gu4_p stl = (gu4_p)st + tid;
        if ((sub & 1) == 0) {
            gcf32_p bl = (gcf32_p)bg + br * 1024 + u.pn * 256 + wc * 32 + 8 * fq;
            f32x4 bv[2][2];
#pragma unroll
            for (int bj = 0; bj < 2; ++bj)
#pragma unroll
                for (int n = 0; n < 2; ++n) bv[bj][n] = *(const GAS f32x4*)(bl + bj * 128 + 4 * n);
#pragma unroll
            for (int ai = 0; ai < 2; ++ai)
#pragma unroll
                for (int bj = 0; bj < 2; ++bj)
#pragma unroll
                    for (int m = 0; m < 4; ++m) { f32x4 g0 = acc[ai][bj][m][0] + bv[bj][0], g1 = acc[ai][bj][m][1] + bv[bj][1];
#pragma unroll
                        for (int e = 0; e < 4; ++e) { g0[e] = fast_sigmoid(g0[e]); g1[e] = fast_sigmoid(g1[e]); }
                        sgl[((ai * 2 + bj) * 4 + m) * 512] = pack8(g0, g1); }
        } else {
            gbf_p lp = (gbf_p)mg + (size_t)(u.pm * 256 + wr * 64 + fr) * 1024 + u.pn * 256 + wc * 32 + 8 * fq;
#pragma unroll
            for (int ai = 0; ai < 2; ++ai)
#pragma unroll
                for (int bj = 0; bj < 2; ++bj)
#pragma unroll
                    for (int m = 0; m < 4; ++m) { const int k16 = ((ai * 2 + bj) * 4 + m) * 512;
                        f32x4 g0, g1; unpack8(sgl[k16], g0, g1);
                        f32x4 v0 = g0 * acc[ai][bj][m][0], v1 = g1 * acc[ai][bj][m][1];
                        if (br > 0) { f32x4 t0, t1; unpack8(stl[k16], t0, t1); v0 += t0; v1 += t1; }
                        const u32x4 w = pack8(v0, v1);
                        if (br < 2) stl[k16] = w;
                        else *(GAS u32x4*)(lp + (ai * 128 + m * 16) * 1024 + bj * 128) = w;
                        asm volatile("" ::: "memory"); }
        }
    }
};
struct EpiRes {
    static constexpr bool PERM = false;
    const float* base_lat; const float* base_ctx; float* out_lat; float* out_ctx; const float* mod; int goff;
    __device__ __forceinline__ void operator()(const f32x4 (&acc)[2][2][4][2], const GUnit& u, int wr, int wc, int fr, int fq) const {
        const bool latent = u.pm < NPAN_LAT;
        const int prow = latent ? u.pm : u.pm - NPAN_LAT;
        const float* base = latent ? base_lat : base_ctx; float* out = latent ? out_lat : out_ctx;
        const int bidx = latent ? (u.pm >> 5) : 4;
        const float* gv = mod + bidx * 6144 + goff;
        OPAQUE_S(base); OPAQUE_S(out); OPAQUE_S(gv);
        const int col0 = u.pn * 256 + wc * 32 + 4 * fq;
        const size_t off0 = (size_t)(prow * 256 + wr * 64 + fr) * 1024 + col0;
        gcf32_p bl = (gcf32_p)base + off0; gf32_p ol = (gf32_p)out + off0; gcf32_p gl = (gcf32_p)gv + col0;
        f32x4 g[2][2];
#pragma unroll
        for (int bj = 0; bj < 2; ++bj)
#pragma unroll
            for (int n = 0; n < 2; ++n) g[bj][n] = *(const GAS f32x4*)(gl + bj * 128 + n * 16);
#pragma unroll
        for (int ai = 0; ai < 2; ++ai)
#pragma unroll
            for (int m = 0; m < 4; ++m) {
#pragma unroll
                for (int bj = 0; bj < 2; ++bj)
#pragma unroll
                    for (int n = 0; n < 2; ++n) { const int o = (ai * 128 + m * 16) * 1024 + bj * 128 + n * 16; const f32x4 b = *(const GAS f32x4*)(bl + o); *(GAS f32x4*)(ol + o) = b + g[bj][n] * acc[ai][bj][m][n]; }
                if (m & 1) asm volatile("" ::: "memory"); }
    }
};
struct EpiSwiglu {
    static constexpr bool PERM = true;
    bf16_t* ACT;
    __device__ __forceinline__ void operator()(const f32x4 (&acc)[2][2][4][2], const GUnit& u, int wr, int wc, int fr, int fq) const {
        bf16_t* actb = ACT; OPAQUE_S(actb);
        gbf_p lp = (gbf_p)actb + (size_t)(u.pm * 256 + wr * 64 + fr) * DFF + u.pn * 128 + wc * 32 + 8 * fq;
#pragma unroll
        for (int ai = 0; ai < 2; ++ai)
#pragma unroll
            for (int m = 0; m < 4; ++m) { f32x4 a0 = acc[ai][0][m][0], a1 = acc[ai][0][m][1];
#pragma unroll
                for (int e = 0; e < 4; ++e) { a0[e] = a0[e] * fast_sigmoid(a0[e]); a1[e] = a1[e] * fast_sigmoid(a1[e]); }
                *(GAS u32x4*)(lp + (ai * 128 + m * 16) * DFF) = pack8(a0 * acc[ai][1][m][0], a1 * acc[ai][1][m][1]); }
    }
};
}

__device__ __forceinline__ int pi32(int m) { return (m & ~12) | ((m & 4) << 1) | ((m & 8) >> 1); }
struct KVF { bf16x8 k[4]; bf16x8 v[4]; };
__device__ __forceinline__ void kv_load(KVF& f, const bf16_t* Kp, int ldk, const bf16_t* VTp, int ldvt, int r32p, int r32, int hi) {
    const bf16_t* kr = Kp + (size_t)r32p * ldk + hi * 8;
#pragma unroll
    for (int d0 = 0; d0 < 4; ++d0) f.k[d0] = *(const bf16x8*)(kr + 16 * d0);
    const bf16_t* v0 = VTp + (size_t)r32 * ldvt + hi * 8; const bf16_t* v1 = v0 + (size_t)32 * ldvt;
    f.v[0] = *(const bf16x8*)(v0); f.v[1] = *(const bf16x8*)(v0 + 16); f.v[2] = *(const bf16x8*)(v1); f.v[3] = *(const bf16x8*)(v1 + 16);
}
__device__ __forceinline__ void attn_compute(const KVF& f, const bf16x8 (&qf)[4], f32x16 s, int maskmode, int r32, int hi, f32x16& o0, f32x16& o1, float& m, float& l) {
#pragma unroll
    for (int d0 = 0; d0 < 4; ++d0) s = __builtin_amdgcn_mfma_f32_32x32x16_bf16(f.k[d0], qf[d0], s, 0, 0, 0);
    if (maskmode != 0) {
#pragma unroll
        for (int r = 0; r < 16; ++r) { const int koff = 16 * (r >> 3) + 8 * hi + (r & 7); const bool ok = (maskmode == 1) ? (koff >= r32) : (koff <= r32); s[r] = ok ? s[r] : NEGBIG; }
    }
    float bm = s[0];
#pragma unroll
    for (int r = 1; r < 16; ++r) bm = fmaxf(bm, s[r]);
    bm = fmaxf(bm, __shfl_xor(bm, 32));
    const float mn = fmaxf(m, bm);
    const float alpha = __builtin_amdgcn_exp2f(m - mn);
    m = mn;
    float ps = 0.f;
#pragma unroll
    for (int r = 0; r < 16; ++r) { s[r] = __builtin_amdgcn_exp2f(s[r] - mn); ps += s[r]; }
    l = l * alpha + ps;
#pragma unroll
    for (int r = 0; r < 16; ++r) { o0[r] *= alpha; o1[r] *= alpha; }
    u32x4 w0, w1;
    w0.x = cvt_pk_bf16(s[0], s[1]); w0.y = cvt_pk_bf16(s[2], s[3]); w0.z = cvt_pk_bf16(s[4], s[5]); w0.w = cvt_pk_bf16(s[6], s[7]);
    w1.x = cvt_pk_bf16(s[8], s[9]); w1.y = cvt_pk_bf16(s[10], s[11]); w1.z = cvt_pk_bf16(s[12], s[13]); w1.w = cvt_pk_bf16(s[14], s[15]);
    const bf16x8 p0 = __builtin_bit_cast(bf16x8, w0), p1 = __builtin_bit_cast(bf16x8, w1);
    o0 = __builtin_amdgcn_mfma_f32_32x32x16_bf16(f.v[0], p0, o0, 0, 0, 0);
    o0 = __builtin_amdgcn_mfma_f32_32x32x16_bf16(f.v[1], p1, o0, 0, 0, 0);
    o1 = __builtin_amdgcn_mfma_f32_32x32x16_bf16(f.v[2], p0, o1, 0, 0, 0);
    o1 = __builtin_amdgcn_mfma_f32_32x32x16_bf16(f.v[3], p1, o1, 0, 0, 0);
}
__device__ __forceinline__ void attn_finish(bf16_t* orow, const f32x16& o0, const f32x16& o1, float l, int hi) {
    const float lt = l + __shfl_xor(l, 32);
    const float inv = 1.0f / lt;
#pragma unroll
    for (int g = 0; g < 4; ++g) {
        u32x2 a, b;
        a.x = cvt_pk_bf16(o0[4 * g] * inv, o0[4 * g + 1] * inv); a.y = cvt_pk_bf16(o0[4 * g + 2] * inv, o0[4 * g + 3] * inv);
        b.x = cvt_pk_bf16(o1[4 * g] * inv, o1[4 * g + 1] * inv); b.y = cvt_pk_bf16(o1[4 * g + 2] * inv, o1[4 * g + 3] * inv);
        *(u32x2*)(orow + 8 * g + 4 * hi) = a; *(u32x2*)(orow + 32 + 8 * g + 4 * hi) = b;
    }
}
__device__ __forceinline__ f32x16 zero16() { f32x16 z;
#pragma unroll
    for (int r = 0; r < 16; ++r) z[r] = 0.f;
    return z; }
__device__ __forceinline__ f32x16 load16(const float* p) { const f32x4 a = *(const f32x4*)p, b = *(const f32x4*)(p + 4), c = *(const f32x4*)(p + 8), d = *(const f32x4*)(p + 12);
    f32x16 z; z[0] = a[0]; z[1] = a[1]; z[2] = a[2]; z[3] = a[3]; z[4] = b[0]; z[5] = b[1]; z[6] = b[2]; z[7] = b[3]; z[8] = c[0]; z[9] = c[1]; z[10] = c[2]; z[11] = c[3]; z[12] = d[0]; z[13] = d[1]; z[14] = d[2]; z[15] = d[3]; return z; }

__device__ __forceinline__ void attn_ctx_blocks(const bf16_t* Kc, int ldk, const bf16_t* Vc, int ldvt, const bf16x8 (&qf)[4], int r32p, int r32, int hi, f32x16& o0, f32x16& o1, float& m, float& l) {
    KVF fa, fb;
    kv_load(fa, Kc, ldk, Vc, ldvt, r32p, r32, hi);
#pragma unroll 1
    for (int kb = 0; kb < 8; kb += 2) {
        kv_load(fb, Kc + (size_t)(kb + 1) * 32 * ldk, ldk, Vc + (kb + 1) * 32, ldvt, r32p, r32, hi);
        attn_compute(fa, qf, zero16(), 0, r32, hi, o0, o1, m, l);
        if (kb + 2 < 8) kv_load(fa, Kc + (size_t)(kb + 2) * 32 * ldk, ldk, Vc + (kb + 2) * 32, ldvt, r32p, r32, hi);
        attn_compute(fb, qf, zero16(), 0, r32, hi, o0, o1, m, l);
    }
}
struct AttnPtrs { bf16_t* QA; const bf16_t* KA; const bf16_t* VAT; bf16_t* QB; const bf16_t* KB; const bf16_t* VBT; const float* CT; const float* sink; };

__device__ __forceinline__ void na_task(const AttnPtrs& P, int l, int b, int h, int r, int half, int lane) {
    const int r32 = lane & 31, hi = lane >> 5, r32p = pi32(r32);
    const size_t qrow = (size_t)b * SEQ + r * 64 + half * 32 + r32;
    bf16_t* qp = P.QA + qrow * 512 + h * 64;
    bf16x8 qf[4];
#pragma unroll
    for (int d0 = 0; d0 < 4; ++d0) qf[d0] = *(const bf16x8*)(qp + d0 * 16 + hi * 8);
    f32x16 o0 = zero16(), o1 = zero16(); float m = -1e30f, lsum = 0.f;
    const bf16_t* Kh = P.KA + h * 64; const bf16_t* Vh = P.VAT + (size_t)(h * 64) * MT;
    attn_ctx_blocks(Kh + (size_t)(MLAT + b * CTXL) * 512, 512, Vh + MLAT + b * CTXL, MT, qf, r32p, r32, hi, o0, o1, m, lsum);
    const int r0 = min(max(r - 4, 0), 120);
    const float* ctb = P.CT + ((size_t)((l * 8 + h) * 15 + (r0 - r + 7)) * 4 + half * 2) * 1024 + lane * 16;
    const size_t key00 = (size_t)b * SEQ + r0 * 64;
    KVF fa, fb; f32x16 ca, cb;
    kv_load(fa, Kh + key00 * 512, 512, Vh + key00, MT, r32p, r32, hi); ca = load16(ctb);
#pragma unroll 1
    for (int j = 0; j < 16; j += 2) {
        kv_load(fb, Kh + (key00 + (j + 1) * 32) * 512, 512, Vh + key00 + (j + 1) * 32, MT, r32p, r32, hi); cb = load16(ctb + (size_t)((j >> 1) * 4 + 1) * 1024);
        attn_compute(fa, qf, ca, 0, r32, hi, o0, o1, m, lsum);
        if (j + 2 < 16) { kv_load(fa, Kh + (key00 + (j + 2) * 32) * 512, 512, Vh + key00 + (j + 2) * 32, MT, r32p, r32, hi); ca = load16(ctb + (size_t)(((j + 2) >> 1) * 4) * 1024); }
        attn_compute(fb, qf, cb, 0, r32, hi, o0, o1, m, lsum);
    }
    attn_finish(qp, o0, o1, lsum, hi);
}
__device__ __forceinline__ void swa_task(const AttnPtrs& P, int l, int b, int h, int qblk, int lane) {
    const int r32 = lane & 31, hi = lane >> 5, r32p = pi32(r32), g = h >> 2;
    const size_t qrow = (size_t)b * SEQ + qblk * 32 + r32;
    bf16_t* qp = P.QB + qrow * 512 + h * 64;
    bf16x8 qf[4];
#pragma unroll
    for (int d0 = 0; d0 < 4; ++d0) qf[d0] = *(const bf16x8*)(qp + d0 * 16 + hi * 8);
    f32x16 o0 = zero16(), o1 = zero16(); float m = P.sink[l * 8 + h] * LOG2E, lsum = (hi == 0) ? 1.f : 0.f;
    const bf16_t* Kh = P.KB + g * 64; const bf16_t* Vh = P.VBT + (size_t)(g * 64) * MT;
    attn_ctx_blocks(Kh + (size_t)(MLAT + b * CTXL) * 128, 128, Vh + MLAT + b * CTXL, MT, qf, r32p, r32, hi, o0, o1, m, lsum);
    const int jlo = (qblk < 4) ? (4 - qblk) : 0, jhi = (qblk > 251) ? (255 - qblk + 4) : 8;
    const size_t kbase = (size_t)b * SEQ + (size_t)(qblk - 4) * 32;
    KVF fa, fb;
    kv_load(fa, Kh + (kbase + jlo * 32) * 128, 128, Vh + kbase + jlo * 32, MT, r32p, r32, hi);
#pragma unroll 1
    for (int j = jlo; j <= jhi; j += 2) {
        if (j + 1 <= jhi) kv_load(fb, Kh + (kbase + (j + 1) * 32) * 128, 128, Vh + kbase + (j + 1) * 32, MT, r32p, r32, hi);
        attn_compute(fa, qf, zero16(), (j == 0) ? 1 : ((j == 8) ? 2 : 0), r32, hi, o0, o1, m, lsum);
        if (j + 2 <= jhi) kv_load(fa, Kh + (kbase + (j + 2) * 32) * 128, 128, Vh + kbase + (j + 2) * 32, MT, r32p, r32, hi);
        if (j + 1 <= jhi) attn_compute(fb, qf, zero16(), (j + 1 == 8) ? 2 : 0, r32, hi, o0, o1, m, lsum);
    }
    attn_finish(qp, o0, o1, lsum, hi);
}
__device__ __forceinline__ void ctx_task(const AttnPtrs& P, int l, int typ, int b, int h, int qblk, int lane) {
    const int r32 = lane & 31, hi = lane >> 5, r32p = pi32(r32);
    const size_t qrow = (size_t)MLAT + b * CTXL + qblk * 32 + r32;
    bf16_t* qp = (typ == 0 ? P.QA : P.QB) + qrow * 512 + h * 64;
    bf16x8 qf[4];
#pragma unroll
    for (int d0 = 0; d0 < 4; ++d0) qf[d0] = *(const bf16x8*)(qp + d0 * 16 + hi * 8);
    f32x16 o0 = zero16(), o1 = zero16(); float m, lsum;
    if (typ == 0) { m = -1e30f; lsum = 0.f;
        attn_ctx_blocks(P.KA + h * 64 + (size_t)(MLAT + b * CTXL) * 512, 512, P.VAT + (size_t)(h * 64) * MT + MLAT + b * CTXL, MT, qf, r32p, r32, hi, o0, o1, m, lsum); }
    else { const int g = h >> 2; m = P.sink[l * 8 + h] * LOG2E; lsum = (hi == 0) ? 1.f : 0.f;
        attn_ctx_blocks(P.KB + g * 64 + (size_t)(MLAT + b * CTXL) * 128, 128, P.VBT + (size_t)(g * 64) * MT + MLAT + b * CTXL, MT, qf, r32p, r32, hi, o0, o1, m, lsum); }
    attn_finish(qp, o0, o1, lsum, hi);
}

__device__ __forceinline__ void transpose_item(const float* W, int K, int N, bf16_t* WT, int ncol0, int nrow0, int k0, LAS float* scr, int lane) {
#pragma unroll 8
    for (int i = 0; i < 32; ++i) { const int kk = 2 * i + (lane >> 5); scr[kk * 33 + (lane & 31)] = W[(size_t)(k0 + kk) * N + ncol0 + (lane & 31)]; }
    LDS_WAIT(); asm volatile("" ::: "memory");
    const int c = lane & 7;
#pragma unroll
    for (int j = 0; j < 4; ++j) { const int n = (lane >> 3) + 8 * j; const LAS float* s = scr + (8 * c) * 33 + n;
        u32x4 o; o.x = cvt_pk_bf16(s[0 * 33], s[1 * 33]); o.y = cvt_pk_bf16(s[2 * 33], s[3 * 33]); o.z = cvt_pk_bf16(s[4 * 33], s[5 * 33]); o.w = cvt_pk_bf16(s[6 * 33], s[7 * 33]);
        *(u32x4*)(WT + (size_t)(nrow0 + n) * K + k0 + 8 * c) = o; }
    LDS_WAIT(); asm volatile("" ::: "memory");
}
__device__ __forceinline__ int srcmap1(int n) {
    if (n < 1024) return n;
    if (n < 1536) { const int t = (n - 1024) >> 8, j = (n - 1024) & 255, half = j >> 7, jj = j & 127; return 1536 + (t * 4 + (jj >> 5)) * 64 + half * 32 + (jj & 31); }
    if (n < 2560) { const int t = (n - 1536) >> 8, j = (n - 1536) & 255, half = j >> 7, jj = j & 127; return (half ? 3328 : 2304) + t * 128 + jj; }
    if (n < 3072) return 2816 + (n - 2560);
    if (n < 3328) { const int j = n - 3072, half = j >> 7, jj = j & 127; if (jj < 64) return 2048 + (jj >> 5) * 64 + half * 32 + (jj & 31); return 2176 + half * 64 + (jj - 64); }
    if (n < 3840) return 1024 + (n - 3328);
    return n;
}
__device__ __forceinline__ int srcmap4(int n) { const int t = n >> 8, j = n & 255; return (j >> 7) * DFF + t * 128 + (j & 127); }

struct Args { const float* in[20]; float* out; unsigned char* ws; int ph_lo, ph_hi; };
constexpr int NPHASE = 2 + 8 * DEPTH;

__global__ void __launch_bounds__(NWAVES * 64, 2) fwd_kernel(Args args) {
    extern __shared__ __attribute__((aligned(16))) unsigned char lds_raw[];
    LAS unsigned char* lds = (LAS unsigned char*)lds_raw;
    const int G = gridDim.x, bx = blockIdx.x;
    const int vcu = (G % 8 == 0) ? (bx % 8) * (G / 8) + bx / 8 : bx;
    const int NGW = G * NWAVES;
#define PHASE_IDS() const int tid = opaque_tid(); const int lane = tid & 63, wave = __builtin_amdgcn_readfirstlane(tid >> 6); const int gw = vcu * NWAVES + wave; (void)lane; (void)gw
    unsigned char* ws = args.ws;
    unsigned* ctl = (unsigned*)(ws + WS_CTL);
    const float* x_in = args.in[0]; const float* c_in = args.in[1]; const float* ctx_in = args.in[2]; const float* cctx_in = args.in[3];
    const float* w_ada = args.in[4]; const float* b_ada = args.in[5]; const float* norm1_g = args.in[6]; const float* norm2_g = args.in[7];
    const float* w_in = args.in[8]; const float* b_gate = args.in[9]; const float* na_rpb = args.in[10]; const float* sw_sink = args.in[11];
    const float* conv_w = args.in[12]; const float* w_br_a = args.in[13]; const float* w_br_b = args.in[14]; const float* w_br_c = args.in[15];
    const float* w_o = args.in[16]; const float* w_up = args.in[17]; const float* w_down = args.in[18]; const float* final_g = args.in[19];
    float* out = args.out;
    float* MOD = (float*)(ws + WS_MOD); float* COS = (float*)(ws + WS_COS); float* SIN = (float*)(ws + WS_SIN); float* CT = (float*)(ws + WS_CT);
    bf16_t* WB = (bf16_t*)(ws + WS_W); bf16_t* H = (bf16_t*)(ws + WS_H); float* XC = (float*)(ws + WS_XC);
    bf16_t* QA = (bf16_t*)(ws + WS_QA); bf16_t* KA = (bf16_t*)(ws + WS_KA); bf16_t* VAT = (bf16_t*)(ws + WS_VAT); bf16_t* QB = (bf16_t*)(ws + WS_QB);
    bf16_t* U = (bf16_t*)(ws + WS_U); bf16_t* CGB = (bf16_t*)(ws + WS_CGB); bf16_t* KB = (bf16_t*)(ws + WS_KB); bf16_t* VBT = (bf16_t*)(ws + WS_VBT);
    bf16_t* MERGED = (bf16_t*)(ws + WS_MERGED); bf16_t* ACT = (bf16_t*)(ws + WS_ACT);

    for (int u = threadIdx.x; u < (LDS_BYTES - LDSCTL_OFF) / 4; u += NWAVES * 64) ((LAS unsigned*)(lds + LDSCTL_OFF))[u] = 0u;
    __syncthreads();
    volatile LAS unsigned* MISC = (volatile LAS unsigned*)(lds + MISC_OFF);
    XcdBarrier bar; bar.bar = ctl + CW_BAR; bar.x = 0; bar.st = nullptr;
#if MK_SINGLE
    bar = xcd_barrier_post(ctl + CW_BAR, MISC + 8);
#endif
    const int lo = args.ph_lo, hi_ph = args.ph_hi;
#define IN(k) (lo <= (k) && (k) < hi_ph)
#define SEAM(k) do { if (IN(k) && IN((k) + 1)) xcd_barrier(bar); } while (0)

    if (IN(0)) {
        PHASE_IDS();
        LAS float* scr = (LAS float*)(lds + RING_OFF + wave * 16384);
        constexpr int I_W1 = (NIN / 32) * (D / 64), I_BR = (D / 32) * (512 / 64), I_WO = (D / 32) * (D / 64), I_W4 = (2 * DFF / 32) * (D / 64), I_W5 = (D / 32) * (DFF / 64);
        constexpr int I_LAYER = I_W1 + 3 * I_BR + I_WO + I_W4 + I_W5;
        for (int it = gw; it < DEPTH * I_LAYER; it += NGW) {
            const int l = it / I_LAYER; int r = it - l * I_LAYER;
            bf16_t* wl = WB + (size_t)l * W_LAYER_ELEMS;
            if (r < I_W1) { const int kb = r / (NIN / 32), nb = r % (NIN / 32); transpose_item(w_in + (size_t)l * D * NIN, D, NIN, wl + WO_W1, srcmap1(nb * 32), nb * 32, kb * 64, scr, lane); continue; } r -= I_W1;
            if (r < 3 * I_BR) { const int br = r / I_BR, rr = r % I_BR, kb = rr / (D / 32), nb = rr % (D / 32); const float* src = (br == 0 ? w_br_a : (br == 1 ? w_br_b : w_br_c)) + (size_t)l * 512 * D;
                transpose_item(src, 512, D, wl + WO_WBR + (size_t)br * D * 512, nb * 32, nb * 32, kb * 64, scr, lane); continue; } r -= 3 * I_BR;
            if (r < I_WO) { const int kb = r / (D / 32), nb = r % (D / 32); transpose_item(w_o + (size_t)l * D * D, D, D, wl + WO_WO, nb * 32, nb * 32, kb * 64, scr, lane); continue; } r -= I_WO;
            if (r < I_W4) { const int kb = r / (2 * DFF / 32), nb = r % (2 * DFF / 32); transpose_item(w_up + (size_t)l * D * 2 * DFF, D, 2 * DFF, wl + WO_W4, srcmap4(nb * 32), nb * 32, kb * 64, scr, lane); continue; } r -= I_W4;
            { const int kb = r / (D / 32), nb = r % (D / 32); transpose_item(w_down + (size_t)l * DFF * D, DFF, D, wl + WO_W5, nb * 32, nb * 32, kb * 64, scr, lane); }
        }
        __syncthreads();
        {
            LAS float* sl = (LAS float*)(lds + RING_OFF);
            LAS float* red = (LAS float*)(lds + RING_OFF + 32768);
            for (int i = tid; i < 5 * D; i += NWAVES * 64) { const int bi = i >> 10, k = i & 1023; const float v = (bi < 4) ? c_in[bi * D + k] : cctx_in[k]; sl[i] = v / (1.0f + __expf(-v)); }
            __syncthreads();
            for (int it = bx; it < DEPTH * 96; it += G) {
                const int l = it / 96, n = (it % 96) * 64 + lane;
                const float* wp = w_ada + ((size_t)l * D + wave * 128) * 6144 + n;
                float a0 = 0.f, a1 = 0.f, a2 = 0.f, a3 = 0.f, a4 = 0.f;
#pragma unroll 8
                for (int k = 0; k < 128; ++k) { const float w = wp[(size_t)k * 6144]; const int kk = wave * 128 + k;
                    a0 += sl[kk] * w; a1 += sl[1024 + kk] * w; a2 += sl[2048 + kk] * w; a3 += sl[3072 + kk] * w; a4 += sl[4096 + kk] * w; }
                red[(wave * 5 + 0) * 64 + lane] = a0; red[(wave * 5 + 1) * 64 + lane] = a1; red[(wave * 5 + 2) * 64 + lane] = a2; red[(wave * 5 + 3) * 64 + lane] = a3; red[(wave * 5 + 4) * 64 + lane] = a4;
                __syncthreads();
                if (tid < 320) { const int bi = tid >> 6, ln = tid & 63; float s = b_ada[l * 6144 + (it % 96) * 64 + ln];
#pragma unroll
                    for (int w = 0; w < 8; ++w) s += red[(w * 5 + bi) * 64 + ln];
                    MOD[((size_t)l * 5 + bi) * 6144 + (it % 96) * 64 + ln] = s; }
                __syncthreads();
            }
        }
        for (int i = gw * 64 + lane; i < SEQ * 32; i += NGW * 64) { const int t = i >> 5, p = i & 31; const float pos = (p < 16) ? (float)(t >> 6) : (float)(t & 63);
            const float inv = powf(10000.0f, -(float)(p & 15) / 16.0f); const float ang = pos * inv; COS[i] = cosf(ang); SIN[i] = sinf(ang); }
        for (int i = gw * 64 + lane; i < DEPTH * 8 * 15 * 4 * 1024; i += NGW * 64) {
            const int r = i & 15, ln = (i >> 4) & 63, kb = (i >> 10) & 1, qb = (i >> 11) & 1; const int rest = i >> 12; const int drow = rest % 15, lh = rest / 15;
            const int q32 = ln & 31, hh = ln >> 5; const int koff = 16 * (r >> 3) + 8 * hh + (r & 7); const int kc = kb * 32 + koff, c = qb * 32 + q32;
            const int c0 = min(max(c - 8, 0), 48); const bool ok = (kc >= c0) && (kc < c0 + 16);
            CT[i] = ok ? na_rpb[((size_t)lh * 15 + drow) * 31 + (kc - c + 15)] * LOG2E : NEGBIG;
        }
    }
    SEAM(0);

    for (int l = 0; l < DEPTH; ++l) {
        const int P = 1 + 8 * l;
        const bool lastl = (l == DEPTH - 1);
        const float* modl = MOD + (size_t)l * 5 * 6144;
        const bf16_t* wl = WB + (size_t)l * W_LAYER_ELEMS;
        const float* xlat = (l == 0) ? x_in : out;
        const float* xctx = (l == 0) ? ctx_in : XC;
        if (IN(P + 0)) {
            PHASE_IDS();
            for (int row = gw; row < MT; row += NGW) {
                const bool latent = row < MLAT; const float* xr = latent ? xlat + (size_t)row * D : xctx + (size_t)(row - MLAT) * D;
                const float* mv = modl + (latent ? (row >> 13) : 4) * 6144; const float* gp = norm1_g + l * D;
                f32x4 v[4]; float ss = 0.f;
#pragma unroll
                for (int j = 0; j < 4; ++j) { v[j] = *(const f32x4*)(xr + 256 * j + 4 * lane); ss += (v[j][0] * v[j][0] + v[j][1] * v[j][1]) + (v[j][2] * v[j][2] + v[j][3] * v[j][3]); }
                const float rinv = 1.0f / sqrtf(wave_sum(ss) * (1.0f / D) + NORM_EPS);
#pragma unroll
                for (int j = 0; j < 4; ++j) { const int c = 256 * j + 4 * lane; const f32x4 g = *(const f32x4*)(gp + c), sh = *(const f32x4*)(mv + c), sc = *(const f32x4*)(mv + 1024 + c);
                    const f32x4 y = (v[j] * rinv * g) * (1.0f + sc) + sh; u32x2 w; w.x = cvt_pk_bf16(y[0], y[1]); w.y = cvt_pk_bf16(y[2], y[3]); *(u32x2*)(H + (size_t)row * D + c) = w; }
            }
        }
        SEAM(P + 0);
        if (IN(P + 1)) {
            pg8::G1Sched S{(const char*)H, (const char*)(wl + WO_W1), NPAN, G, bx};
            pg8::EpiG1 E{QA, KA, VAT, QB, U, CGB, KB, VBT, COS, SIN};
            pg8::gemm_phase<pg8::EpiG1, pg8::G1Sched>(lds + RING_OFF, S, E);
        }
        SEAM(P + 1);
        if (IN(P + 2)) {
            PHASE_IDS();
            AttnPtrs AP{QA, KA, VAT, QB, KB, VBT, CT, sw_sink};
            for (int t = gw; t < NBATCH * 8 * 256; t += NGW) { const int bh = t >> 8, r = (t >> 1) & 127, half = t & 1; na_task(AP, l, bh >> 3, bh & 7, r, half, lane); }
            for (int t = gw; t < NBATCH * 8 * 256; t += NGW) { const int bh = t >> 8, qblk = t & 255; swa_task(AP, l, bh >> 3, bh & 7, qblk, lane); }
            if (!lastl) for (int t = gw; t < 2 * NBATCH * 8 * 8; t += NGW) { const int typ = t >> 8, bh = (t >> 3) & 31, qblk = t & 7; ctx_task(AP, l, typ, bh >> 3, bh & 7, qblk, lane); }
            const int nrows = lastl ? MLAT : MT;
            const float* cw = conv_w + (size_t)l * 3 * 512;
            for (int it = gw * 64 + lane; it < nrows * 64; it += NGW * 64) {
                const int row = it >> 6, ch = (it & 63) * 8;
                const bool latent = row < MLAT; const int tl = latent ? (row & (SEQ - 1)) : ((row - MLAT) & (CTXL - 1)); const int tmax = latent ? SEQ - 1 : CTXL - 1;
                const u32x4 zero = {0u, 0u, 0u, 0u};
                const u32x4 um = (tl > 0) ? *(const u32x4*)(U + (size_t)(row - 1) * 512 + ch) : zero;
                const u32x4 uc = *(const u32x4*)(U + (size_t)row * 512 + ch);
                const u32x4 up = (tl < tmax) ? *(const u32x4*)(U + (size_t)(row + 1) * 512 + ch) : zero;
                const u32x4 gb = *(const u32x4*)(CGB + (size_t)row * 512 + ch);
                f32x4 m0, m1, c0, c1, p0, p1, g0, g1; unpack8(um, m0, m1); unpack8(uc, c0, c1); unpack8(up, p0, p1); unpack8(gb, g0, g1);
                const f32x4 w00 = *(const f32x4*)(cw + ch), w01 = *(const f32x4*)(cw + ch + 4), w10 = *(const f32x4*)(cw + 512 + ch), w11 = *(const f32x4*)(cw + 512 + ch + 4), w20 = *(const f32x4*)(cw + 1024 + ch), w21 = *(const f32x4*)(cw + 1024 + ch + 4);
                const f32x4 y0 = g0 * (w00 * m0 + w10 * c0 + w20 * p0), y1 = g1 * (w01 * m1 + w11 * c1 + w21 * p1);
                *(u32x4*)(CGB + (size_t)row * 512 + ch) = pack8(y0, y1);
            }
        }
        SEAM(P + 2);
        const int nMl = lastl ? NPAN_LAT : NPAN;
        if (IN(P + 3)) {
            pg8::G2Sched S{(const char*)H, (const char*)(wl + WO_W1), (const char*)QA, (const char*)(wl + WO_WBR), nMl, G, bx};
            u32x4* scrg = (u32x4*)(ws + WS_SCR + (size_t)bx * 262144);
            pg8::EpiG2 E{scrg, scrg + 8192, MERGED, b_gate + (size_t)l * 3072};
            pg8::gemm_phase<pg8::EpiG2, pg8::G2Sched>(lds + RING_OFF, S, E);
        }
        SEAM(P + 3);
        if (IN(P + 4)) {
            pg8::SimpleSched S{(const char*)MERGED, (const char*)(wl + WO_WO), 2048, 2048, 16, nMl, 4, G, bx};
            pg8::EpiRes E{xlat, xctx, out, XC, modl, 2048};
            pg8::gemm_phase<pg8::EpiRes, pg8::SimpleSched>(lds + RING_OFF, S, E);
        }
        SEAM(P + 4);
        if (IN(P + 5)) {
            PHASE_IDS();
            const int nrows = lastl ? MLAT : MT;
            for (int row = gw; row < nrows; row += NGW) {
                const bool latent = row < MLAT; const float* xr = latent ? out + (size_t)row * D : XC + (size_t)(row - MLAT) * D;
                const float* mv = modl + (latent ? (row >> 13) : 4) * 6144 + 3072; const float* gp = norm2_g + l * D;
                f32x4 v[4]; float ss = 0.f;
#pragma unroll
                for (int j = 0; j < 4; ++j) { v[j] = *(const f32x4*)(xr + 256 * j + 4 * lane); ss += (v[j][0] * v[j][0] + v[j][1] * v[j][1]) + (v[j][2] * v[j][2] + v[j][3] * v[j][3]); }
                const float rinv = 1.0f / sqrtf(wave_sum(ss) * (1.0f / D) + NORM_EPS);
#pragma unroll
                for (int j = 0; j < 4; ++j) { const int c = 256 * j + 4 * lane; const f32x4 g = *(const f32x4*)(gp + c), sh = *(const f32x4*)(mv + c), sc = *(const f32x4*)(mv + 1024 + c);
                    const f32x4 y = (v[j] * rinv * g) * (1.0f + sc) + sh; u32x2 w; w.x = cvt_pk_bf16(y[0], y[1]); w.y = cvt_pk_bf16(y[2], y[3]); *(u32x2*)(H + (size_t)row * D + c) = w; }
            }
        }
        SEAM(P + 5);
        if (IN(P + 6)) {
            pg8::SimpleSched S{(const char*)H, (const char*)(wl + WO_W4), 2048, 2048, 16, nMl, 22, G, bx};
            pg8::EpiSwiglu E{ACT};
            pg8::gemm_phase<pg8::EpiSwiglu, pg8::SimpleSched>(lds + RING_OFF, S, E);
        }
        SEAM(P + 6);
        if (IN(P + 7)) {
            pg8::SimpleSched S{(const char*)ACT, (const char*)(wl + WO_W5), 2 * DFF, 2 * DFF, DFF / 64, nMl, 4, G, bx};
            pg8::EpiRes E{out, XC, out, XC, modl, 5120};
            pg8::gemm_phase<pg8::EpiRes, pg8::SimpleSched>(lds + RING_OFF, S, E);
        }
        SEAM(P + 7);
    }
    if (IN(NPHASE - 1)) {
        PHASE_IDS();
        for (int row = gw; row < MLAT; row += NGW) {
            float* xr = out + (size_t)row * D;
            f32x4 v[4]; float ss = 0.f;
#pragma unroll
            for (int j = 0; j < 4; ++j) { v[j] = *(const f32x4*)(xr + 256 * j + 4 * lane); ss += (v[j][0] * v[j][0] + v[j][1] * v[j][1]) + (v[j][2] * v[j][2] + v[j][3] * v[j][3]); }
            const float rinv = 1.0f / sqrtf(wave_sum(ss) * (1.0f / D) + NORM_EPS);
#pragma unroll
            for (int j = 0; j < 4; ++j) { const int c = 256 * j + 4 * lane; const f32x4 g = *(const f32x4*)(final_g + c); *(f32x4*)(xr + c) = v[j] * rinv * g; }
        }
    }
#undef IN
#undef SEAM
}

extern "C" void kernel_launch(void* const* d_in, const int* in_sizes, int n_in, void* d_out, int out_size, void* d_ws, size_t ws_size, hipStream_t stream) {
    static int grid = 0;
    if (grid == 0) {
        if (n_in != 20 || in_sizes[0] != MLAT * D || out_size != MLAT * D || ws_size < WS_END) {
            fprintf(stderr, "kernel_launch: unexpected shapes: n_in %d in0 %d out %d ws %zu (need %zu); nothing launched\n", n_in, n_in > 0 ? in_sizes[0] : -1, out_size, ws_size, (size_t)WS_END); grid = -1; return; }
        int dev = 0, cus = 0, per_cu = 0;
        if (hipGetDevice(&dev) != hipSuccess || hipDeviceGetAttribute(&cus, hipDeviceAttributeMultiprocessorCount, dev) != hipSuccess) { fprintf(stderr, "kernel_launch: device query failed\n"); grid = -1; return; }
        if (hipFuncSetAttribute((const void*)fwd_kernel, hipFuncAttributeMaxDynamicSharedMemorySize, LDS_BYTES) != hipSuccess) { fprintf(stderr, "kernel_launch: hipFuncSetAttribute failed\n"); grid = -1; return; }
        if (hipOccupancyMaxActiveBlocksPerMultiprocessor(&per_cu, (const void*)fwd_kernel, NWAVES * 64, LDS_BYTES) != hipSuccess || per_cu < 1)
            fprintf(stderr, "kernel_launch: note: occupancy query reports %d workgroups per CU\n", per_cu);
        (void)hipGetLastError();
        grid = cus > 256 ? 256 : cus;
    }
    if (grid < 0) return;
    if (hipMemsetAsync((char*)d_ws + WS_CTL, 0, CTL_ZERO_BYTES, stream) != hipSuccess) { fprintf(stderr, "kernel_launch: memset failed\n"); return; }
    Args a{};
    for (int i = 0; i < 20; ++i) a.in[i] = (const float*)d_in[i];
    a.out = (float*)d_out; a.ws = (unsigned char*)d_ws;
#if MK_SINGLE
    a.ph_lo = 0; a.ph_hi = NPHASE;
    hipLaunchKernelGGL(fwd_kernel, dim3(grid), dim3(NWAVES * 64), LDS_BYTES, stream, a);
#else
    for (int p = 0; p < NPHASE; ++p) { a.ph_lo = p; a.ph_hi = p + 1; hipLaunchKernelGGL(fwd_kernel, dim3(grid), dim3(NWAVES * 64), LDS_BYTES, stream, a); }
#endif
    const hipError_t le = hipPeekAtLastError();
    if (le != hipSuccess) fprintf(stderr, "kernel_launch: launch failed: %s\n", hipGetErrorName(le));
}
```

```cpp
#include <hip/hip_runtime.h>
#include <cstdio>
#include <cstdint>

#ifndef MK_SINGLE
#define MK_SINGLE 1
#endif

#define GAS __attribute__((address_space(1)))
#define LAS __attribute__((address_space(3)))
typedef unsigned short bf16_t;
typedef short bf16x8 __attribute__((ext_vector_type(8)));
typedef float f32x4 __attribute__((ext_vector_type(4)));
typedef float f32x2 __attribute__((ext_vector_type(2)));
typedef float f32x16 __attribute__((ext_vector_type(16)));
typedef unsigned u32x4 __attribute__((ext_vector_type(4)));
typedef unsigned u32x2 __attribute__((ext_vector_type(2)));

constexpr int D = 1024, NBATCH = 4, SEQ = 8192, DEPTH = 4, CTXL = 256;
constexpr int MLAT = NBATCH * SEQ;
constexpr int MCTX = NBATCH * CTXL;
constexpr int MT = MLAT + MCTX;
constexpr int NPAN = MT / 256;
constexpr int NPAN_LAT = MLAT / 256;
constexpr int NIN = 6912, DFF = 2816;
constexpr float NORM_EPS = 1e-6f;
constexpr float LOG2E = 1.4426950408889634f;
constexpr float C2 = 0.125f * LOG2E;
constexpr float NEGBIG = -30000.0f;

constexpr size_t MiB = 1u << 20;
constexpr size_t WS_CTL = 0, CTL_ZERO_BYTES = 1 * MiB;
constexpr size_t WS_MOD = 1 * MiB;
constexpr size_t WS_COS = 2 * MiB, WS_SIN = 3 * MiB;
constexpr size_t WS_CT = 4 * MiB;
constexpr size_t WS_W = 12 * MiB;
constexpr size_t W_LAYER_ELEMS = 18350080;
constexpr size_t WO_W1 = 0, WO_WBR = 7077888, WO_WO = 8650752, WO_W4 = 9699328, WO_W5 = 15466496;
constexpr size_t WS_H = 152 * MiB;
constexpr size_t WS_XC = 218 * MiB;
constexpr size_t WS_Z = 222 * MiB;
constexpr size_t Z33 = 33 * MiB;
constexpr size_t WS_QA = WS_Z, WS_QB = WS_Z + Z33, WS_CGB = WS_Z + 2 * Z33, WS_KA = WS_Z + 3 * Z33, WS_VAT = WS_Z + 4 * Z33, WS_U = WS_Z + 5 * Z33;
constexpr size_t WS_KB = WS_Z + 6 * Z33, WS_VBT = WS_KB + (size_t)MT * 128 * 2;
constexpr size_t WS_MERGED = WS_KA;
constexpr size_t WS_ACT = WS_Z;
constexpr size_t WS_SCR = 437 * MiB;
constexpr size_t WS_END = 501 * MiB;
static_assert(WS_VBT + (size_t)MT * 128 * 2 <= WS_SCR, "ws map");
static_assert(WS_ACT + (size_t)MT * DFF * 2 <= WS_KB, "act overlay");
static_assert(WS_W + 4 * W_LAYER_ELEMS * 2 <= WS_H, "weights");

constexpr int CW_BAR = 4096;

constexpr int RING_OFF = 0, RING_BYTES = 131072;
constexpr int LDSCTL_OFF = RING_BYTES, MISC_OFF = LDSCTL_OFF + 320;
constexpr int LDS_BYTES = 147456;
constexpr int NWAVES = 8;

__device__ __forceinline__ unsigned cvt_pk_bf16(float lo, float hi) { unsigned r; asm volatile("v_cvt_pk_bf16_f32 %0, %1, %2" : "=v"(r) : "v"(lo), "v"(hi)); return r; }
__device__ __forceinline__ float bf_lo(unsigned w) { return __uint_as_float(w << 16); }
__device__ __forceinline__ float bf_hi(unsigned w) { return __uint_as_float(w & 0xffff0000u); }
__device__ __forceinline__ unsigned short f2bf(float f) { return (unsigned short)(cvt_pk_bf16(f, 0.f) & 0xffffu); }
__device__ __forceinline__ float fast_sigmoid(float x) { return __builtin_amdgcn_rcpf(1.0f + __builtin_amdgcn_exp2f(-x * LOG2E)); }
__device__ __forceinline__ u32x4 pack8(f32x4 a, f32x4 b) { u32x4 w; w.x = cvt_pk_bf16(a[0], a[1]); w.y = cvt_pk_bf16(a[2], a[3]); w.z = cvt_pk_bf16(b[0], b[1]); w.w = cvt_pk_bf16(b[2], b[3]); return w; }
__device__ __forceinline__ void unpack8(u32x4 w, f32x4& a, f32x4& b) { a[0] = bf_lo(w.x); a[1] = bf_hi(w.x); a[2] = bf_lo(w.y); a[3] = bf_hi(w.y); b[0] = bf_lo(w.z); b[1] = bf_hi(w.z); b[2] = bf_lo(w.w); b[3] = bf_hi(w.w); }
__device__ __forceinline__ float wave_sum(float v) {
#pragma unroll
    for (int o = 1; o < 64; o <<= 1) v += __shfl_xor(v, o);
    return v;
}
#define LDS_WAIT() asm volatile("s_waitcnt lgkmcnt(0)" ::: "memory")
__device__ __forceinline__ int opaque_tid() { int t = threadIdx.x; asm volatile("" : "+v"(t)); return t; }
typedef GAS bf16_t* gbf_p; typedef GAS float* gf32_p; typedef const GAS float* gcf32_p; typedef GAS u32x4* gu4_p;
#define OPAQUE_S(p) asm volatile("" : "+s"(p))

#define XB_TMO      128
#define XB_XCNT(j)  (256  + 64 * (j))
#define XB_XSUB(j)  (1280 + 64 * (j))
#define XB_XGEN(j)  (2304 + 64 * (j))
#define XB_TOP      3328
#define XB_TOPGEN   3392
#define XCD_BAR_WORDS 3456
#define XB_SPIN_CAP (1u << 18)
__device__ __forceinline__ unsigned xb_ld(unsigned* p)              { return __hip_atomic_load(p, __ATOMIC_RELAXED, __HIP_MEMORY_SCOPE_AGENT); }
__device__ __forceinline__ unsigned xb_add(unsigned* p, unsigned v) { return __hip_atomic_fetch_add(p, v, __ATOMIC_RELAXED, __HIP_MEMORY_SCOPE_AGENT); }
__device__ __forceinline__ unsigned xb_xcc_id() { return (unsigned)__builtin_amdgcn_s_getreg((3 << 11) | 20) & 0xFu; }
#define XB_SPIN(cond, bar) do { unsigned _sp = 0; while (cond) { __builtin_amdgcn_s_sleep(1); \
    if ((++_sp & 255u) == 0u) { if (xb_ld(&(bar)[XB_TMO])) break; if (_sp > XB_SPIN_CAP) { atomicAdd(&(bar)[XB_TMO], 1u); break; } } } } while (0)
struct XcdBarrier { unsigned* bar; unsigned x; volatile LAS unsigned* st; };
__device__ __forceinline__ XcdBarrier xcd_barrier_post(unsigned* bar, volatile LAS unsigned* st) {
    XcdBarrier b; b.bar = bar; b.x = xb_xcc_id(); b.st = st;
    if (threadIdx.x == 0) (void)xb_add(&bar[XB_XCNT(b.x)], 1u);
    return b;
}
__device__ __forceinline__ void xcd_barrier_complete(unsigned* bar, unsigned x, unsigned& nloc, unsigned& nx) {
    const unsigned G = gridDim.x * gridDim.y * gridDim.z;
    unsigned sum, cnt, mine, sp = 0u;
    for (;;) {
        sum = 0u; cnt = 0u; mine = 0u;
#pragma unroll
        for (unsigned j = 0; j < 16; ++j) { const unsigned c = xb_ld(&bar[XB_XCNT(j)]); sum += c; cnt += (c > 0u) ? 1u : 0u; mine = (j == x) ? c : mine; }
        if (sum == G) break;
        __builtin_amdgcn_s_sleep(1);
        if ((++sp & 255u) == 0u) { if (xb_ld(&bar[XB_TMO])) break; if (sp > XB_SPIN_CAP) { atomicAdd(&bar[XB_TMO], 1u); break; } }
    }
    nloc = mine > 0u ? mine : 1u; nx = cnt > 0u ? cnt : 1u;
}
__device__ __forceinline__ void xcd_barrier(const XcdBarrier& b) {
    asm volatile("s_waitcnt vmcnt(0)" ::: "memory");
    __syncthreads();
    if (threadIdx.x == 0) {
        unsigned* bar = b.bar;
        __builtin_amdgcn_s_waitcnt(0);
        unsigned nloc = b.st[0], nx = b.st[1];
        if (nloc == 0u) { xcd_barrier_complete(bar, b.x, nloc, nx); b.st[0] = nloc; b.st[1] = nx; }
        const unsigned old = xb_add(&bar[XB_XSUB(b.x)], 1u);
        const unsigned gen = old / nloc;
        if (old + 1u == (gen + 1u) * nloc) {
            __builtin_amdgcn_fence(__ATOMIC_RELEASE, "agent");
            asm volatile("s_waitcnt vmcnt(0)" ::: "memory");
            const unsigned og = xb_add(&bar[XB_TOP], 1u);
            const unsigned tg = og / nx;
            if (og + 1u == (tg + 1u) * nx) xb_add(&bar[XB_TOPGEN], 1u);
            else XB_SPIN(xb_ld(&bar[XB_TOPGEN]) == tg, bar);
            __builtin_amdgcn_fence(__ATOMIC_ACQUIRE, "agent");
            xb_add(&bar[XB_XGEN(b.x)], 1u);
            asm volatile("s_waitcnt vmcnt(0)" ::: "memory");
        } else {
            XB_SPIN(xb_ld(&bar[XB_XGEN(b.x)]) == gen, bar);
            __builtin_amdgcn_fence(__ATOMIC_ACQUIRE, "agent");
            asm volatile("s_waitcnt vmcnt(0)" ::: "memory");
        }
    }
    __syncthreads();
}

namespace pg8 {
constexpr int BM = 256, BK = 64, HALF = 128, HTB = HALF * BK * 2, STAGE_BYTES = 8 * HTB, NXCD = 8, WGM = 8;
__host__ __device__ __forceinline__ int lds_byte(int r, int c) { const int st = (r >> 4) * 2 + (c >> 5), rr = r & 15, cc = c & 31, ob = rr * 64 + cc * 2; return st * 1024 + (ob ^ (((ob >> 9) & 1) << 5)); }
__host__ __device__ __forceinline__ void stage_rc(int b, int& R, int& C) { const int st = b / 1024, sb = b % 1024, swz = sb ^ (((sb >> 9) & 1) << 5); R = (st >> 1) * 16 + swz / 64; C = (st & 1) * 32 + (swz % 64) / 2; }
__host__ __device__ __forceinline__ int perm32(int rho) { const int n = rho >> 4, i = rho & 15; return 8 * (i >> 2) + 4 * n + (i & 3); }

struct GUnit { const char* A; const char* B; unsigned lda2, ldb2; int nt; int pm, pn, mode; };

__device__ __forceinline__ bool tile_order(long L, int nM, int nN, int& pm, int& pn) {
    const int nwg = nM * nN; if (L >= nwg) return false;
    int wgid = (int)L; { const int q = nwg / NXCD, r = nwg % NXCD, xcd = wgid % NXCD, off = wgid / NXCD; wgid = (xcd < r ? xcd * (q + 1) : r * (q + 1) + (xcd - r) * q) + off; }
    const int nig = WGM * nN, gid = wgid / nig, fm = gid * WGM, gsz = (nM - fm) < WGM ? (nM - fm) : WGM;
    pm = fm + ((wgid % nig) % gsz); pn = (wgid % nig) / gsz; return true;
}

template <class Epi, class Sched>
__device__ __forceinline__ void gemm_phase(LAS unsigned char* lds, const Sched& S, const Epi& E) {
    const int tid = opaque_tid(), wid = __builtin_amdgcn_readfirstlane(tid >> 6), lane = tid & 63, wr = wid >> 2, wc = wid & 3, fr = lane & 15, fq = lane >> 4;
    unsigned sR[2], sRb[2], sC[2];
#pragma unroll
    for (int i = 0; i < 2; ++i) { int R, C; stage_rc(tid * 16 + i * 8192, R, C); sR[i] = (unsigned)R; sRb[i] = (unsigned)(Epi::PERM ? ((R & ~31) + perm32(R & 31)) : R); sC[i] = (unsigned)C * 2u; }
    const size_t kstep = (size_t)(BK * 2);
    const unsigned ldsw = (unsigned)wid * 1024u;
    const int aoff = lds_byte(wr * 64 + fr, fq * 8), boff = lds_byte(wc * 32 + fr, fq * 8);
#define PG8_SA(b, h) (((b) * 2 + (h)) * HTB)
#define PG8_SB(b, h) ((4 + (b) * 2 + (h)) * HTB)
#define PG8_STAGE(bufoff, gbase, voff) do { _Pragma("unroll") for (int _i = 0; _i < 2; ++_i) \
        __builtin_amdgcn_global_load_lds((const unsigned*)((const char*)(gbase) + (voff)[_i]), (LAS unsigned*)(lds + (bufoff) + ldsw + _i * 8192), 16, 0, 0); } while (0)
#define PG8_LDA(dst, b, h) do { _Pragma("unroll") for (int m = 0; m < 4; ++m) _Pragma("unroll") for (int k = 0; k < 2; ++k) dst[m][k] = *(const LAS bf16x8*)(lds + PG8_SA(b, h) + aoff + m * 2048 + k * 1024); } while (0)
#define PG8_LDB(dst, b, h) do { _Pragma("unroll") for (int n = 0; n < 2; ++n) _Pragma("unroll") for (int k = 0; k < 2; ++k) dst[n][k] = *(const LAS bf16x8*)(lds + PG8_SB(b, h) + boff + n * 2048 + k * 1024); } while (0)
#define PG8_MMA(ai, bj, At, Bt) do { __builtin_amdgcn_s_setprio(1); _Pragma("unroll") for (int m = 0; m < 4; ++m) _Pragma("unroll") for (int n = 0; n < 2; ++n) _Pragma("unroll") for (int k = 0; k < 2; ++k) \
        acc[ai][bj][m][n] = __builtin_amdgcn_mfma_f32_16x16x32_bf16(Bt[n][k], At[m][k], acc[ai][bj][m][n], 0, 0, 0); __builtin_amdgcn_s_setprio(0); } while (0)
#define PG8_WAIT_V(n) asm volatile("s_waitcnt vmcnt(" #n ")" ::: "memory")
#define PG8_WAIT_L(n) asm volatile("s_waitcnt lgkmcnt(" #n ")" ::: "memory")
#define PG8_BAR __builtin_amdgcn_s_barrier()
#define PG8_SCHED __builtin_amdgcn_sched_barrier(0)
#define PG8_VOFF(u, vA, vB) do { _Pragma("unroll") for (int _i = 0; _i < 2; ++_i) { vA[_i] = sR[_i] * (u).lda2 + sC[_i]; vB[_i] = sRb[_i] * (u).ldb2 + sC[_i]; } } while (0)
    GUnit cur, nxt; int ui = 0;
    if (!S.next(0, cur)) return;
    f32x4 acc[2][2][4][2];
#pragma unroll
    for (int a = 0; a < 2; ++a)
#pragma unroll
        for (int b = 0; b < 2; ++b)
#pragma unroll
            for (int m = 0; m < 4; ++m)
#pragma unroll
                for (int n = 0; n < 2; ++n) acc[a][b][m][n] = (f32x4){0.f, 0.f, 0.f, 0.f};
    bf16x8 At[4][2], B0[2][2], B1[2][2];
    unsigned vA[2], vB[2], nvA[2], nvB[2];
    PG8_VOFF(cur, vA, vB);
    const char* cA = cur.A; const char* cB = cur.B;
    size_t hA = (size_t)HALF * cur.lda2, hB = (size_t)HALF * cur.ldb2;
    PG8_STAGE(PG8_SB(0, 0), cB, vB); PG8_STAGE(PG8_SB(0, 1), cB + hB, vB); PG8_STAGE(PG8_SA(0, 0), cA, vA); PG8_STAGE(PG8_SA(0, 1), cA + hA, vA);
    if (wr == 1) PG8_BAR;
    PG8_WAIT_V(2); PG8_BAR;
    PG8_STAGE(PG8_SB(1, 0), cB + kstep, vB); PG8_STAGE(PG8_SA(1, 0), cA + kstep, vA); PG8_STAGE(PG8_SB(1, 1), cB + hB + kstep, vB);
    PG8_WAIT_V(6); PG8_BAR;
    for (;;) {
        const bool has_next = S.next(ui + 1, nxt);
        const char* nA = cA; const char* nB = cB; size_t nhA = hA, nhB = hB;
        nvA[0] = vA[0]; nvA[1] = vA[1]; nvB[0] = vB[0]; nvB[1] = vB[1];
        if (has_next) { nA = nxt.A; nB = nxt.B; nhA = (size_t)HALF * nxt.lda2; nhB = (size_t)HALF * nxt.ldb2; PG8_VOFF(nxt, nvA, nvB); }
        const int nt = cur.nt;
        for (int t = 0; t < nt; t += 2) {
            const bool last = (t == nt - 2);
            const char* a1 = cA + (size_t)(t + 1) * kstep;
            const char* a2 = last ? nA : cA + (size_t)(t + 2) * kstep; const char* b2 = last ? nB : cB + (size_t)(t + 2) * kstep;
            const char* a3 = a2 + kstep; const char* b3 = b2 + kstep;
            unsigned wA[2], wB[2]; wA[0] = last ? nvA[0] : vA[0]; wA[1] = last ? nvA[1] : vA[1]; wB[0] = last ? nvB[0] : vB[0]; wB[1] = last ? nvB[1] : vB[1];
            const size_t hA2 = last ? nhA : hA, hB2 = last ? nhB : hB;
            PG8_LDB(B0, 0, 0); PG8_LDB(B1, 0, 1); PG8_SCHED; PG8_LDA(At, 0, 0); PG8_STAGE(PG8_SA(1, 1), a1 + hA, vA);
            PG8_WAIT_V(8); PG8_WAIT_L(0); PG8_BAR; PG8_MMA(0, 0, At, B0); PG8_MMA(0, 1, At, B1); PG8_BAR; PG8_SCHED;
            PG8_LDA(At, 0, 1); PG8_STAGE(PG8_SB(0, 0), b2, wB); PG8_STAGE(PG8_SB(0, 1), b2 + hB2, wB); PG8_STAGE(PG8_SA(0, 0), a2, wA);
            PG8_WAIT_V(8); PG8_WAIT_L(0); PG8_BAR; PG8_MMA(1, 0, At, B0); PG8_MMA(1, 1, At, B1); PG8_BAR; PG8_SCHED;
            PG8_LDB(B0, 1, 0); PG8_LDB(B1, 1, 1); PG8_SCHED; PG8_LDA(At, 1, 0); PG8_STAGE(PG8_SA(0, 1), a2 + hA2, wA);
            PG8_WAIT_V(8); PG8_WAIT_L(0); PG8_BAR; PG8_MMA(0, 0, At, B0); PG8_MMA(0, 1, At, B1); PG8_BAR; PG8_SCHED;
            PG8_LDA(At, 1, 1); PG8_STAGE(PG8_SB(1, 0), b3, wB); PG8_STAGE(PG8_SB(1, 1), b3 + hB2, wB); PG8_STAGE(PG8_SA(1, 0), a3, wA);
            PG8_WAIT_V(8); PG8_WAIT_L(0); PG8_BAR; PG8_MMA(1, 0, At, B0); PG8_MMA(1, 1, At, B1); PG8_BAR; PG8_SCHED;
        }
        if (wr == 0) PG8_BAR;
        E(acc, cur, wr, wc, fr, fq);
        if (!has_next) break;
#pragma unroll
        for (int a = 0; a < 2; ++a)
#pragma unroll
            for (int b = 0; b < 2; ++b)
#pragma unroll
                for (int m = 0; m < 4; ++m)
#pragma unroll
                    for (int n = 0; n < 2; ++n) acc[a][b][m][n] = (f32x4){0.f, 0.f, 0.f, 0.f};
        cur = nxt; cA = nA; cB = nB; hA = nhA; hB = nhB; vA[0] = nvA[0]; vA[1] = nvA[1]; vB[0] = nvB[0]; vB[1] = nvB[1]; ++ui;
        if (wr == 1) PG8_BAR;
    }
    PG8_WAIT_V(0);
    PG8_BAR;
#undef PG8_SA
#undef PG8_SB
#undef PG8_STAGE
#undef PG8_LDA
#undef PG8_LDB
#undef PG8_MMA
#undef PG8_WAIT_V
#undef PG8_WAIT_L
#undef PG8_BAR
#undef PG8_SCHED
#undef PG8_VOFF
}

struct SimpleSched {
    const char* A; const char* B; unsigned lda2, ldb2; int nt, nM, nN, G, c;
    __device__ __forceinline__ bool next(int i, GUnit& u) const {
        int pm, pn; if (!tile_order((long)i * G + c, nM, nN, pm, pn)) return false;
        u.A = A + (size_t)pm * 256 * lda2; u.B = B + (size_t)pn * 256 * ldb2; u.lda2 = lda2; u.ldb2 = ldb2; u.nt = nt; u.pm = pm; u.pn = pn; u.mode = 0; return true;
    }
};
struct G1Sched {
    const char* H; const char* W1; int nM, G, c;
    __device__ __forceinline__ bool next(int i, GUnit& u) const {
        int pm, pn; if (!tile_order((long)i * G + c, nM, 15, pm, pn)) return false;
        const char* hp = H + (size_t)pm * 256 * 2048;
        if (pn < 13) { u.A = hp; u.B = W1 + (size_t)pn * 256 * 2048; } else { u.A = W1 + (size_t)(3328 + (pn - 13) * 256) * 2048; u.B = hp; }
        u.lda2 = 2048; u.ldb2 = 2048; u.nt = 16; u.pm = pm; u.pn = pn; u.mode = 0; return true;
    }
};
struct G2Sched {
    const char* H; const char* W1; const char* OA; const char* WBR; int nM, G, c;
    __device__ __forceinline__ bool next(int i, GUnit& u) const {
        const int tile = i / 6, sub = i - tile * 6, br = sub >> 1;
        int pm, pn; if (!tile_order((long)tile * G + c, nM, 4, pm, pn)) return false;
        if ((sub & 1) == 0) { u.A = H + (size_t)pm * 256 * 2048; u.B = W1 + (size_t)(3840 + br * 1024 + pn * 256) * 2048; u.lda2 = 2048; u.ldb2 = 2048; u.nt = 16; }
        else { u.A = OA + (size_t)br * Z33 + (size_t)pm * 256 * 1024; u.B = WBR + (size_t)(br * 1024 + pn * 256) * 1024; u.lda2 = 1024; u.ldb2 = 1024; u.nt = 8; }
        u.pm = pm; u.pn = pn; u.mode = sub; return true;
    }
};

struct EpiG1 {
    static constexpr bool PERM = true;
    bf16_t *QA, *KA, *VAT, *QB, *U, *CGB, *KB, *VBT; const float *COS, *SIN;
    __device__ __forceinline__ void operator()(const f32x4 (&acc)[2][2][4][2], const GUnit& u, int wr, int wc, int fr, int fq) const {
        const int pn = u.pn;
        const int row0 = u.pm * 256 + wr * 64 + fr;
        const bool latent = u.pm < NPAN_LAT;
        if (pn < 4 || pn == 10 || pn == 11) {
            bf16_t* base; float sc = 1.f; int colt;
            if (pn < 2) { base = QA; sc = C2; colt = pn * 256; } else if (pn < 4) { base = KA; colt = (pn - 2) * 256; } else { base = CGB; colt = (pn - 10) * 256; }
            OPAQUE_S(base);
            gbf_p lp = (gbf_p)base + (size_t)row0 * 512 + colt + wc * 32 + 8 * fq;
#pragma unroll
            for (int ai = 0; ai < 2; ++ai)
#pragma unroll
                for (int m = 0; m < 4; ++m)
#pragma unroll
                    for (int bj = 0; bj < 2; ++bj) *(GAS u32x4*)(lp + (ai * 128 + m * 16) * 512 + bj * 128) = pack8(acc[ai][bj][m][0] * sc, acc[ai][bj][m][1] * sc);
        } else if (pn < 6 || (pn == 12 && wc < 2)) {
            const bool isq = pn < 6;
            bf16_t* base = isq ? QB : KB; const int ld = isq ? 512 : 128; const int head = isq ? (pn - 4) * 4 + wc : wc; const float sc = isq ? C2 : 1.f;
            const float* cosb = COS; const float* sinb = SIN; OPAQUE_S(base); OPAQUE_S(cosb); OPAQUE_S(sinb);
            gbf_p lp = (gbf_p)base + (size_t)row0 * ld + head * 64 + 8 * fq;
            const int t0 = ((u.pm & 31) * 256 + wr * 64 + fr) * 32 + 8 * fq;
            gcf32_p cl = (gcf32_p)cosb + t0; gcf32_p sl = (gcf32_p)sinb + t0;
#pragma unroll
            for (int ai = 0; ai < 2; ++ai)
#pragma unroll
                for (int m = 0; m < 4; ++m) {
                    f32x4 x1a = acc[ai][0][m][0], x1b = acc[ai][0][m][1], x2a = acc[ai][1][m][0], x2b = acc[ai][1][m][1];
                    f32x4 o1a = x1a, o1b = x1b, o2a = x2a, o2b = x2b;
                    if (latent) { gcf32_p cp = cl + (ai * 128 + m * 16) * 32; gcf32_p sp = sl + (ai * 128 + m * 16) * 32;
                        const f32x4 ca = *(const GAS f32x4*)cp, cb = *(const GAS f32x4*)(cp + 4), sa = *(const GAS f32x4*)sp, sb = *(const GAS f32x4*)(sp + 4);
                        o1a = x1a * ca - x2a * sa; o1b = x1b * cb - x2b * sb; o2a = x1a * sa + x2a * ca; o2b = x1b * sb + x2b * cb; }
                    gbf_p rowp = lp + (size_t)(ai * 128 + m * 16) * ld;
                    *(GAS u32x4*)(rowp) = pack8(o1a * sc, o1b * sc); *(GAS u32x4*)(rowp + 32) = pack8(o2a * sc, o2b * sc); asm volatile("" ::: "memory"); }
        } else if (pn < 10) {
            bf16_t* ub = U; OPAQUE_S(ub);
            gbf_p lp = (gbf_p)ub + (size_t)row0 * 512 + (pn - 6) * 128 + wc * 32 + 8 * fq;
#pragma unroll
            for (int ai = 0; ai < 2; ++ai)
#pragma unroll
                for (int m = 0; m < 4; ++m) *(GAS u32x4*)(lp + (ai * 128 + m * 16) * 512) = pack8(acc[ai][0][m][0] * acc[ai][1][m][0], acc[ai][0][m][1] * acc[ai][1][m][1]);
        } else if (pn == 12) {
            bf16_t* vbt = VBT; OPAQUE_S(vbt);
            gbf_p lp = (gbf_p)vbt + (size_t)((wc - 2) * 32 + 8 * fq) * MT + row0;
#pragma unroll
            for (int ai = 0; ai < 2; ++ai)
#pragma unroll
                for (int m = 0; m < 4; ++m)
#pragma unroll
                    for (int bj = 0; bj < 2; ++bj)
#pragma unroll
                        for (int n = 0; n < 2; ++n)
#pragma unroll
                            for (int e = 0; e < 4; ++e) lp[(size_t)(bj * 64 + 4 * n + e) * MT + ai * 128 + m * 16] = f2bf(acc[ai][bj][m][n][e]);
        } else {
            bf16_t* vat = VAT; OPAQUE_S(vat);
            gbf_p lp = (gbf_p)vat + (size_t)((pn - 13) * 256 + wr * 64 + fr) * MT + u.pm * 256 + wc * 32 + 8 * fq;
#pragma unroll
            for (int ai = 0; ai < 2; ++ai)
#pragma unroll
                for (int m = 0; m < 4; ++m)
#pragma unroll
                    for (int bj = 0; bj < 2; ++bj) *(GAS u32x4*)(lp + (size_t)(ai * 128 + m * 16) * MT + bj * 128) = pack8(acc[ai][bj][m][0], acc[ai][bj][m][1]);
        }
    }
};
struct EpiG2 {
    static constexpr bool PERM = true;
    u32x4* SG; u32x4* ST; bf16_t* MERGED; const float* bgate;
    __device__ __forceinline__ void operator()(const f32x4 (&acc)[2][2][4][2], const GUnit& u, int wr, int wc, int fr, int fq) const {
        const int sub = u.mode, br = sub >> 1, tid = (wr * 4 + wc) * 64 + fq * 16 + fr;
        u32x4* sg = SG; u32x4* st = ST; bf16_t* mg = MERGED; const float* bg = bgate; OPAQUE_S(sg); OPAQUE_S(st); OPAQUE_S(mg); OPAQUE_S(bg);
        gu4_p sgl = (gu4_p)sg + tid; gu4_p stl = (gu4_p)st + tid;
        if ((sub & 1) == 0) {
            gcf32_p bl = (gcf32_p)bg + br * 1024 + u.pn * 256 + wc * 32 + 8 * fq;
            f32x4 bv[2][2];
#pragma unroll
            for (int bj = 0; bj < 2; ++bj)
#pragma unroll
                for (int n = 0; n < 2; ++n) bv[bj][n] = *(const GAS f32x4*)(bl + bj * 128 + 4 * n);
#pragma unroll
            for (int ai = 0; ai < 2; ++ai)
#pragma unroll
                for (int bj = 0; bj < 2; ++bj)
#pragma unroll
                    for (int m = 0; m < 4; ++m) { f32x4 g0 = acc[ai][bj][m][0] + bv[bj][0], g1 = acc[ai][bj][m][1] + bv[bj][1];
#pragma unroll
                        for (int e = 0; e < 4; ++e) { g0[e] = fast_sigmoid(g0[e]); g1[e] = fast_sigmoid(g1[e]); }
                        sgl[((ai * 2 + bj) * 4 + m) * 512] = pack8(g0, g1); }
        } else {
            gbf_p lp = (gbf_p)mg + (size_t)(u.pm * 256 + wr * 64 + fr) * 1024 + u.pn * 256 + wc * 32 + 8 * fq;
#pragma unroll
            for (int ai = 0; ai < 2; ++ai)
#pragma unroll
                for (int bj = 0; bj < 2; ++bj)
#pragma unroll
                    for (int m = 0; m < 4; ++m) { const int k16 = ((ai * 2 + bj) * 4 + m) * 512;
                        f32x4 g0, g1; unpack8(sgl[k16], g0, g1);
                        f32x4 v0 = g0 * acc[ai][bj][m][0], v1 = g1 * acc[ai][bj][m][1];
                        if (br > 0) { f32x4 t0, t1; unpack8(stl[k16], t0, t1); v0 += t0; v1 += t1; }
                        const u32x4 w = pack8(v0, v1);
                        if (br < 2) stl[k16] = w;
                        else *(GAS u32x4*)(lp + (ai * 128 + m * 16) * 1024 + bj * 128) = w;
                        asm volatile("" ::: "memory"); }
        }
    }
};
struct EpiRes {
    static constexpr bool PERM = false;
    const float* base_lat; const float* base_ctx; float* out_lat; float* out_ctx; const float* mod; int goff;
    __device__ __forceinline__ void operator()(const f32x4 (&acc)[2][2][4][2], const GUnit& u, int wr, int wc, int fr, int fq) const {
        const bool latent = u.pm < NPAN_LAT;
        const int prow = latent ? u.pm : u.pm - NPAN_LAT;
        const float* base = latent ? base_lat : base_ctx; float* out = latent ? out_lat : out_ctx;
        const int bidx = latent ? (u.pm >> 5) : 4;
        const float* gv = mod + bidx * 6144 + goff;
        OPAQUE_S(base); OPAQUE_S(out); OPAQUE_S(gv);
        const int col0 = u.pn * 256 + wc * 32 + 4 * fq;
        const size_t off0 = (size_t)(prow * 256 + wr * 64 + fr) * 1024 + col0;
        gcf32_p bl = (gcf32_p)base + off0; gf32_p ol = (gf32_p)out + off0; gcf32_p gl = (gcf32_p)gv + col0;
        f32x4 g[2][2];
#pragma unroll
        for (int bj = 0; bj < 2; ++bj)
#pragma unroll
            for (int n = 0; n < 2; ++n) g[bj][n] = *(const GAS f32x4*)(gl + bj * 128 + n * 16);
#pragma unroll
        for (int ai = 0; ai < 2; ++ai)
#pragma unroll
            for (int m = 0; m < 4; ++m) {
#pragma unroll
                for (int bj = 0; bj < 2; ++bj)
#pragma unroll
                    for (int n = 0; n < 2; ++n) { const int o = (ai * 128 + m * 16) * 1024 + bj * 128 + n * 16; const f32x4 b = *(const GAS f32x4*)(bl + o); *(GAS f32x4*)(ol + o) = b + g[bj][n] * acc[ai][bj][m][n]; }
                if (m & 1) asm volatile("" ::: "memory"); }
    }
};
struct EpiSwiglu {
    static constexpr bool PERM = true;
    bf16_t* ACT;
    __device__ __forceinline__ void operator()(const f32x4 (&acc)[2][2][4][2], const GUnit& u, int wr, int wc, int fr, int fq) const {
        bf16_t* actb = ACT; OPAQUE_S(actb);
        gbf_p lp = (gbf_p)actb + (size_t)(u.pm * 256 + wr * 64 + fr) * DFF + u.pn * 128 + wc * 32 + 8 * fq;
#pragma unroll
        for (int ai = 0; ai < 2; ++ai)
#pragma unroll
            for (int m = 0; m < 4; ++m) { f32x4 a0 = acc[ai][0][m][0], a1 = acc[ai][0][m][1];
#pragma unroll
                for (int e = 0; e < 4; ++e) { a0[e] = a0[e] * fast_sigmoid(a0[e]); a1[e] = a1[e] * fast_sigmoid(a1[e]); }
                *(GAS u32x4*)(lp + (ai * 128 + m * 16) * DFF) = pack8(a0 * acc[ai][1][m][0], a1 * acc[ai][1][m][1]); }
    }
};
}

__device__ __forceinline__ int pi32(int m) { return (m & ~12) | ((m & 4) << 1) | ((m & 8) >> 1); }
struct KVF { bf16x8 k[4]; bf16x8 v[4]; };
__device__ __forceinline__ void kv_load(KVF& f, const bf16_t* Kp, int ldk, const bf16_t* VTp, int ldvt, int r32p, int r32, int hi) {
    const bf16_t* kr = Kp + (size_t)r32p * ldk + hi * 8;
#pragma unroll
    for (int d0 = 0; d0 < 4; ++d0) f.k[d0] = *(const bf16x8*)(kr + 16 * d0);
    const bf16_t* v0 = VTp + (size_t)r32 * ldvt + hi * 8; const bf16_t* v1 = v0 + (size_t)32 * ldvt;
    f.v[0] = *(const bf16x8*)(v0); f.v[1] = *(const bf16x8*)(v0 + 16); f.v[2] = *(const bf16x8*)(v1); f.v[3] = *(const bf16x8*)(v1 + 16);
}
__device__ __forceinline__ void attn_compute(const KVF& f, const bf16x8 (&qf)[4], f32x16 s, int maskmode, int r32, int hi, f32x16& o0, f32x16& o1, float& m, float& l) {
#pragma unroll
    for (int d0 = 0; d0 < 4; ++d0) s = __builtin_amdgcn_mfma_f32_32x32x16_bf16(f.k[d0], qf[d0], s, 0, 0, 0);
    if (maskmode != 0) {
#pragma unroll
        for (int r = 0; r < 16; ++r) { const int koff = 16 * (r >> 3) + 8 * hi + (r & 7); const bool ok = (maskmode == 1) ? (koff >= r32) : (koff <= r32); s[r] = ok ? s[r] : NEGBIG; }
    }
    float bm = s[0];
#pragma unroll
    for (int r = 1; r < 16; ++r) bm = fmaxf(bm, s[r]);
    bm = fmaxf(bm, __shfl_xor(bm, 32));
    const float mn = fmaxf(m, bm);
    const float alpha = __builtin_amdgcn_exp2f(m - mn);
    m = mn;
    float ps = 0.f;
#pragma unroll
    for (int r = 0; r < 16; ++r) { s[r] = __builtin_amdgcn_exp2f(s[r] - mn); ps += s[r]; }
    l = l * alpha + ps;
#pragma unroll
    for (int r = 0; r < 16; ++r) { o0[r] *= alpha; o1[r] *= alpha; }
    u32x4 w0, w1;
    w0.x = cvt_pk_bf16(s[0], s[1]); w0.y = cvt_pk_bf16(s[2], s[3]); w0.z = cvt_pk_bf16(s[4], s[5]); w0.w = cvt_pk_bf16(s[6], s[7]);
    w1.x = cvt_pk_bf16(s[8], s[9]); w1.y = cvt_pk_bf16(s[10], s[11]); w1.z = cvt_pk_bf16(s[12], s[13]); w1.w = cvt_pk_bf16(s[14], s[15]);
    const bf16x8 p0 = __builtin_bit_cast(bf16x8, w0), p1 = __builtin_bit_cast(bf16x8, w1);
    o0 = __builtin_amdgcn_mfma_f32_32x32x16_bf16(f.v[0], p0, o0, 0, 0, 0);
    o0 = __builtin_amdgcn_mfma_f32_32x32x16_bf16(f.v[1], p1, o0, 0, 0, 0);
    o1 = __builtin_amdgcn_mfma_f32_32x32x16_bf16(f.v[2], p0, o1, 0, 0, 0);
    o1 = __builtin_amdgcn_mfma_f32_32x32x16_bf16(f.v[3], p1, o1, 0, 0, 0);
}
__device__ __forceinline__ void attn_finish(bf16_t* orow, const f32x16& o0, const f32x16& o1, float l, int hi) {
    const float lt = l + __shfl_xor(l, 32);
    const float inv = 1.0f / lt;
#pragma unroll
    for (int g = 0; g < 4; ++g) {
        u32x2 a, b;
        a.x = cvt_pk_bf16(o0[4 * g] * inv, o0[4 * g + 1] * inv); a.y = cvt_pk_bf16(o0[4 * g + 2] * inv, o0[4 * g + 3] * inv);
        b.x = cvt_pk_bf16(o1[4 * g] * inv, o1[4 * g + 1] * inv); b.y = cvt_pk_bf16(o1[4 * g + 2] * inv, o1[4 * g + 3] * inv);
        *(u32x2*)(orow + 8 * g + 4 * hi) = a; *(u32x2*)(orow + 32 + 8 * g + 4 * hi) = b;
    }
}
__device__ __forceinline__ f32x16 zero16() { f32x16 z;
#pragma unroll
    for (int r = 0; r < 16; ++r) z[r] = 0.f;
    return z; }
__device__ __forceinline__ f32x16 load16(const float* p) { const f32x4 a = *(const f32x4*)p, b = *(const f32x4*)(p + 4), c = *(const f32x4*)(p + 8), d = *(const f32x4*)(p + 12);
    f32x16 z; z[0] = a[0]; z[1] = a[1]; z[2] = a[2]; z[3] = a[3]; z[4] = b[0]; z[5] = b[1]; z[6] = b[2]; z[7] = b[3]; z[8] = c[0]; z[9] = c[1]; z[10] = c[2]; z[11] = c[3]; z[12] = d[0]; z[13] = d[1]; z[14] = d[2]; z[15] = d[3]; return z; }

__device__ __forceinline__ void attn_ctx_blocks(const bf16_t* Kc, int ldk, const bf16_t* Vc, int ldvt, const bf16x8 (&qf)[4], int r32p, int r32, int hi, f32x16& o0, f32x16& o1, float& m, float& l) {
    KVF fa, fb;
    kv_load(fa, Kc, ldk, Vc, ldvt, r32p, r32, hi);
#pragma unroll 1
    for (int kb = 0; kb < 8; kb += 2) {
        kv_load(fb, Kc + (size_t)(kb + 1) * 32 * ldk, ldk, Vc + (kb + 1) * 32, ldvt, r32p, r32, hi);
        attn_compute(fa, qf, zero16(), 0, r32, hi, o0, o1, m, l);
        if (kb + 2 < 8) kv_load(fa, Kc + (size_t)(kb + 2) * 32 * ldk, ldk, Vc + (kb + 2) * 32, ldvt, r32p, r32, hi);
        attn_compute(fb, qf, zero16(), 0, r32, hi, o0, o1, m, l);
    }
}
struct AttnPtrs { bf16_t* QA; const bf16_t* KA; const bf16_t* VAT; bf16_t* QB; const bf16_t* KB; const bf16_t* VBT; const float* CT; const float* sink; };

__device__ __forceinline__ void na_task(const AttnPtrs& P, int l, int b, int h, int r, int half, int lane) {
    const int r32 = lane & 31, hi = lane >> 5, r32p = pi32(r32);
    const size_t qrow = (size_t)b * SEQ + r * 64 + half * 32 + r32;
    bf16_t* qp = P.QA + qrow * 512 + h * 64;
    bf16x8 qf[4];
#pragma unroll
    for (int d0 = 0; d0 < 4; ++d0) qf[d0] = *(const bf16x8*)(qp + d0 * 16 + hi * 8);
    f32x16 o0 = zero16(), o1 = zero16(); float m = -1e30f, lsum = 0.f;
    const bf16_t* Kh = P.KA + h * 64; const bf16_t* Vh = P.VAT + (size_t)(h * 64) * MT;
    attn_ctx_blocks(Kh + (size_t)(MLAT + b * CTXL) * 512, 512, Vh + MLAT + b * CTXL, MT, qf, r32p, r32, hi, o0, o1, m, lsum);
    const int r0 = min(max(r - 4, 0), 120);
    const float* ctb = P.CT + ((size_t)((l * 8 + h) * 15 + (r0 - r + 7)) * 4 + half * 2) * 1024 + lane * 16;
    const size_t key00 = (size_t)b * SEQ + r0 * 64;
    KVF fa, fb; f32x16 ca, cb;
    kv_load(fa, Kh + key00 * 512, 512, Vh + key00, MT, r32p, r32, hi); ca = load16(ctb);
#pragma unroll 1
    for (int j = 0; j < 16; j += 2) {
        kv_load(fb, Kh + (key00 + (j + 1) * 32) * 512, 512, Vh + key00 + (j + 1) * 32, MT, r32p, r32, hi); cb = load16(ctb + (size_t)((j >> 1) * 4 + 1) * 1024);
        attn_compute(fa, qf, ca, 0, r32, hi, o0, o1, m, lsum);
        if (j + 2 < 16) { kv_load(fa, Kh + (key00 + (j + 2) * 32) * 512, 512, Vh + key00 + (j + 2) * 32, MT, r32p, r32, hi); ca = load16(ctb + (size_t)(((j + 2) >> 1) * 4) * 1024); }
        attn_compute(fb, qf, cb, 0, r32, hi, o0, o1, m, lsum);
    }
    attn_finish(qp, o0, o1, lsum, hi);
}
__device__ __forceinline__ void swa_task(const AttnPtrs& P, int l, int b, int h, int qblk, int lane) {
    const int r32 = lane & 31, hi = lane >> 5, r32p = pi32(r32), g = h >> 2;
    const size_t qrow = (size_t)b * SEQ + qblk * 32 + r32;
    bf16_t* qp = P.QB + qrow * 512 + h * 64;
    bf16x8 qf[4];
#pragma unroll
    for (int d0 = 0; d0 < 4; ++d0) qf[d0] = *(const bf16x8*)(qp + d0 * 16 + hi * 8);
    f32x16 o0 = zero16(), o1 = zero16(); float m = P.sink[l * 8 + h] * LOG2E, lsum = (hi == 0) ? 1.f : 0.f;
    const bf16_t* Kh = P.KB + g * 64; const bf16_t* Vh = P.VBT + (size_t)(g * 64) * MT;
    attn_ctx_blocks(Kh + (size_t)(MLAT + b * CTXL) * 128, 128, Vh + MLAT + b * CTXL, MT, qf, r32p, r32, hi, o0, o1, m, lsum);
    const int jlo = (qblk < 4) ? (4 - qblk) : 0, jhi = (qblk > 251) ? (255 - qblk + 4) : 8;
    const size_t kbase = (size_t)b * SEQ + (size_t)(qblk - 4) * 32;
    KVF fa, fb;
    kv_load(fa, Kh + (kbase + jlo * 32) * 128, 128, Vh + kbase + jlo * 32, MT, r32p, r32, hi);
#pragma unroll 1
    for (int j = jlo; j <= jhi; j += 2) {
        if (j + 1 <= jhi) kv_load(fb, Kh + (kbase + (j + 1) * 32) * 128, 128, Vh + kbase + (j + 1) * 32, MT, r32p, r32, hi);
        attn_compute(fa, qf, zero16(), (j == 0) ? 1 : ((j == 8) ? 2 : 0), r32, hi, o0, o1, m, lsum);
        if (j + 2 <= jhi) kv_load(fa, Kh + (kbase + (j + 2) * 32) * 128, 128, Vh + kbase + (j + 2) * 32, MT, r32p, r32, hi);
        if (j + 1 <= jhi) attn_compute(fb, qf, zero16(), (j + 1 == 8) ? 2 : 0, r32, hi, o0, o1, m, lsum);
    }
    attn_finish(qp, o0, o1, lsum, hi);
}
__device__ __forceinline__ void ctx_task(const AttnPtrs& P, int l, int typ, int b, int h, int qblk, int lane) {
    const int r32 = lane & 31, hi = lane >> 5, r32p = pi32(r32);
    const size_t qrow = (size_t)MLAT + b * CTXL + qblk * 32 + r32;
    bf16_t* qp = (typ == 0 ? P.QA : P.QB) + qrow * 512 + h * 64;
    bf16x8 qf[4];
#pragma unroll
    for (int d0 = 0; d0 < 4; ++d0) qf[d0] = *(const bf16x8*)(qp + d0 * 16 + hi * 8);
    f32x16 o0 = zero16(), o1 = zero16(); float m, lsum;
    if (typ == 0) { m = -1e30f; lsum = 0.f;
        attn_ctx_blocks(P.KA + h * 64 + (size_t)(MLAT + b * CTXL) * 512, 512, P.VAT + (size_t)(h * 64) * MT + MLAT + b * CTXL, MT, qf, r32p, r32, hi, o0, o1, m, lsum); }
    else { const int g = h >> 2; m = P.sink[l * 8 + h] * LOG2E; lsum = (hi == 0) ? 1.f : 0.f;
        attn_ctx_blocks(P.KB + g * 64 + (size_t)(MLAT + b * CTXL) * 128, 128, P.VBT + (size_t)(g * 64) * MT + MLAT + b * CTXL, MT, qf, r32p, r32, hi, o0, o1, m, lsum); }
    attn_finish(qp, o0, o1, lsum, hi);
}

__device__ __forceinline__ void transpose_item(const float* W, int K, int N, bf16_t* WT, int ncol0, int nrow0, int k0, LAS float* scr, int lane) {
#pragma unroll 8
    for (int i = 0; i < 32; ++i) { const int kk = 2 * i + (lane >> 5); scr[kk * 33 + (lane & 31)] = W[(size_t)(k0 + kk) * N + ncol0 + (lane & 31)]; }
    LDS_WAIT(); asm volatile("" ::: "memory");
    const int c = lane & 7;
#pragma unroll
    for (int j = 0; j < 4; ++j) { const int n = (lane >> 3) + 8 * j; const LAS float* s = scr + (8 * c) * 33 + n;
        u32x4 o; o.x = cvt_pk_bf16(s[0 * 33], s[1 * 33]); o.y = cvt_pk_bf16(s[2 * 33], s[3 * 33]); o.z = cvt_pk_bf16(s[4 * 33], s[5 * 33]); o.w = cvt_pk_bf16(s[6 * 33], s[7 * 33]);
        *(u32x4*)(WT + (size_t)(nrow0 + n) * K + k0 + 8 * c) = o; }
    LDS_WAIT(); asm volatile("" ::: "memory");
}
__device__ __forceinline__ int srcmap1(int n) {
    if (n < 1024) return n;
    if (n < 1536) { const int t = (n - 1024) >> 8, j = (n - 1024) & 255, half = j >> 7, jj = j & 127; return 1536 + (t * 4 + (jj >> 5)) * 64 + half * 32 + (jj & 31); }
    if (n < 2560) { const int t = (n - 1536) >> 8, j = (n - 1536) & 255, half = j >> 7, jj = j & 127; return (half ? 3328 : 2304) + t * 128 + jj; }
    if (n < 3072) return 2816 + (n - 2560);
    if (n < 3328) { const int j = n - 3072, half = j >> 7, jj = j & 127; if (jj < 64) return 2048 + (jj >> 5) * 64 + half * 32 + (jj & 31); return 2176 + half * 64 + (jj - 64); }
    if (n < 3840) return 1024 + (n - 3328);
    return n;
}
__device__ __forceinline__ int srcmap4(int n) { const int t = n >> 8, j = n & 255; return (j >> 7) * DFF + t * 128 + (j & 127); }

struct Args { const float* in[20]; float* out; unsigned char* ws; int ph_lo, ph_hi; };
constexpr int NPHASE = 2 + 8 * DEPTH;

__global__ void __launch_bounds__(NWAVES * 64, 2) fwd_kernel(Args args) {
    extern __shared__ __attribute__((aligned(16))) unsigned char lds_raw[];
    LAS unsigned char* lds = (LAS unsigned char*)lds_raw;
    const int G = gridDim.x, bx = blockIdx.x;
    const int vcu = (G % 8 == 0) ? (bx % 8) * (G / 8) + bx / 8 : bx;
    const int NGW = G * NWAVES;
#define PHASE_IDS() const int tid = opaque_tid(); const int lane = tid & 63, wave = __builtin_amdgcn_readfirstlane(tid >> 6); const int gw = vcu * NWAVES + wave; (void)lane; (void)gw
    unsigned char* ws = args.ws;
    unsigned* ctl = (unsigned*)(ws + WS_CTL);
    const float* x_in = args.in[0]; const float* c_in = args.in[1]; const float* ctx_in = args.in[2]; const float* cctx_in = args.in[3];
    const float* w_ada = args.in[4]; const float* b_ada = args.in[5]; const float* norm1_g = args.in[6]; const float* norm2_g = args.in[7];
    const float* w_in = args.in[8]; const float* b_gate = args.in[9]; const float* na_rpb = args.in[10]; const float* sw_sink = args.in[11];
    const float* conv_w = args.in[12]; const float* w_br_a = args.in[13]; const float* w_br_b = args.in[14]; const float* w_br_c = args.in[15];
    const float* w_o = args.in[16]; const float* w_up = args.in[17]; const float* w_down = args.in[18]; const float* final_g = args.in[19];
    float* out = args.out;
    float* MOD = (float*)(ws + WS_MOD); float* COS = (float*)(ws + WS_COS); float* SIN = (float*)(ws + WS_SIN); float* CT = (float*)(ws + WS_CT);
    bf16_t* WB = (bf16_t*)(ws + WS_W); bf16_t* H = (bf16_t*)(ws + WS_H); float* XC = (float*)(ws + WS_XC);
    bf16_t* QA = (bf16_t*)(ws + WS_QA); bf16_t* KA = (bf16_t*)(ws + WS_KA); bf16_t* VAT = (bf16_t*)(ws + WS_VAT); bf16_t* QB = (bf16_t*)(ws + WS_QB);
    bf16_t* U = (bf16_t*)(ws + WS_U); bf16_t* CGB = (bf16_t*)(ws + WS_CGB); bf16_t* KB = (bf16_t*)(ws + WS_KB); bf16_t* VBT = (bf16_t*)(ws + WS_VBT);
    bf16_t* MERGED = (bf16_t*)(ws + WS_MERGED); bf16_t* ACT = (bf16_t*)(ws + WS_ACT);

    for (int u = threadIdx.x; u < (LDS_BYTES - LDSCTL_OFF) / 4; u += NWAVES * 64) ((LAS unsigned*)(lds + LDSCTL_OFF))[u] = 0u;
    __syncthreads();
    volatile LAS unsigned* MISC = (volatile LAS unsigned*)(lds + MISC_OFF);
    XcdBarrier bar; bar.bar = ctl + CW_BAR; bar.x = 0; bar.st = nullptr;
#if MK_SINGLE
    bar = xcd_barrier_post(ctl + CW_BAR, MISC + 8);
#endif
    const int lo = args.ph_lo, hi_ph = args.ph_hi;
#define IN(k) (lo <= (k) && (k) < hi_ph)
#define SEAM(k) do { if (IN(k) && IN((k) + 1)) xcd_barrier(bar); } while (0)

    if (IN(0)) {
        PHASE_IDS();
        LAS float* scr = (LAS float*)(lds + RING_OFF + wave * 16384);
        constexpr int I_W1 = (NIN / 32) * (D / 64), I_BR = (D / 32) * (512 / 64), I_WO = (D / 32) * (D / 64), I_W4 = (2 * DFF / 32) * (D / 64), I_W5 = (D / 32) * (DFF / 64);
        constexpr int I_LAYER = I_W1 + 3 * I_BR + I_WO + I_W4 + I_W5;
        for (int it = gw; it < DEPTH * I_LAYER; it += NGW) {
            const int l = it / I_LAYER; int r = it - l * I_LAYER;
            bf16_t* wl = WB + (size_t)l * W_LAYER_ELEMS;
            if (r < I_W1) { const int kb = r / (NIN / 32), nb = r % (NIN / 32); transpose_item(w_in + (size_t)l * D * NIN, D, NIN, wl + WO_W1, srcmap1(nb * 32), nb * 32, kb * 64, scr, lane); continue; } r -= I_W1;
            if (r < 3 * I_BR) { const int br = r / I_BR, rr = r % I_BR, kb = rr / (D / 32), nb = rr % (D / 32); const float* src = (br == 0 ? w_br_a : (br == 1 ? w_br_b : w_br_c)) + (size_t)l * 512 * D;
                transpose_item(src, 512, D, wl + WO_WBR + (size_t)br * D * 512, nb * 32, nb * 32, kb * 64, scr, lane); continue; } r -= 3 * I_BR;
            if (r < I_WO) { const int kb = r / (D / 32), nb = r % (D / 32); transpose_item(w_o + (size_t)l * D * D, D, D, wl + WO_WO, nb * 32, nb * 32, kb * 64, scr, lane); continue; } r -= I_WO;
            if (r < I_W4) { const int kb = r / (2 * DFF / 32), nb = r % (2 * DFF / 32); transpose_item(w_up + (size_t)l * D * 2 * DFF, D, 2 * DFF, wl + WO_W4, srcmap4(nb * 32), nb * 32, kb * 64, scr, lane); continue; } r -= I_W4;
            { const int kb = r / (D / 32), nb = r % (D / 32); transpose_item(w_down + (size_t)l * DFF * D, DFF, D, wl + WO_W5, nb * 32, nb * 32, kb * 64, scr, lane); }
        }
        __syncthreads();
        {
            LAS float* sl = (LAS float*)(lds + RING_OFF);
            LAS float* red = (LAS float*)(lds + RING_OFF + 32768);
            for (int i = tid; i < 5 * D; i += NWAVES * 64) { const int bi = i >> 10, k = i & 1023; const float v = (bi < 4) ? c_in[bi * D + k] : cctx_in[k]; sl[i] = v / (1.0f + __expf(-v)); }
            __syncthreads();
            for (int it = bx; it < DEPTH * 96; it += G) {
                const int l = it / 96, n = (it % 96) * 64 + lane;
                const float* wp = w_ada + ((size_t)l * D + wave * 128) * 6144 + n;
                float a0 = 0.f, a1 = 0.f, a2 = 0.f, a3 = 0.f, a4 = 0.f;
#pragma unroll 8
                for (int k = 0; k < 128; ++k) { const float w = wp[(size_t)k * 6144]; const int kk = wave * 128 + k;
                    a0 += sl[kk] * w; a1 += sl[1024 + kk] * w; a2 += sl[2048 + kk] * w; a3 += sl[3072 + kk] * w; a4 += sl[4096 + kk] * w; }
                red[(wave * 5 + 0) * 64 + lane] = a0; red[(wave * 5 + 1) * 64 + lane] = a1; red[(wave * 5 + 2) * 64 + lane] = a2; red[(wave * 5 + 3) * 64 + lane] = a3; red[(wave * 5 + 4) * 64 + lane] = a4;
                __syncthreads();
                if (tid < 320) { const int bi = tid >> 6, ln = tid & 63; float s = b_ada[l * 6144 + (it % 96) * 64 + ln];
#pragma unroll
                    for (int w = 0; w < 8; ++w) s += red[(w * 5 + bi) * 64 + ln];
                    MOD[((size_t)l * 5 + bi) * 6144 + (it % 96) * 64 + ln] = s; }
                __syncthreads();
            }
        }
        for (int i = gw * 64 + lane; i < SEQ * 32; i += NGW * 64) { const int t = i >> 5, p = i & 31; const float pos = (p < 16) ? (float)(t >> 6) : (float)(t & 63);
            const float inv = powf(10000.0f, -(float)(p & 15) / 16.0f); const float ang = pos * inv; COS[i] = cosf(ang); SIN[i] = sinf(ang); }
        for (int i = gw * 64 + lane; i < DEPTH * 8 * 15 * 4 * 1024; i += NGW * 64) {
            const int r = i & 15, ln = (i >> 4) & 63, kb = (i >> 10) & 1, qb = (i >> 11) & 1; const int rest = i >> 12; const int drow = rest % 15, lh = rest / 15;
            const int q32 = ln & 31, hh = ln >> 5; const int koff = 16 * (r >> 3) + 8 * hh + (r & 7); const int kc = kb * 32 + koff, c = qb * 32 + q32;
            const int c0 = min(max(c - 8, 0), 48); const bool ok = (kc >= c0) && (kc < c0 + 16);
            CT[i] = ok ? na_rpb[((size_t)lh * 15 + drow) * 31 + (kc - c + 15)] * LOG2E : NEGBIG;
        }
    }
    SEAM(0);

    for (int l = 0; l < DEPTH; ++l) {
        const int P = 1 + 8 * l;
        const bool lastl = (l == DEPTH - 1);
        const float* modl = MOD + (size_t)l * 5 * 6144;
        const bf16_t* wl = WB + (size_t)l * W_LAYER_ELEMS;
        const float* xlat = (l == 0) ? x_in : out;
        const float* xctx = (l == 0) ? ctx_in : XC;
        if (IN(P + 0)) {
            PHASE_IDS();
            for (int row = gw; row < MT; row += NGW) {
                const bool latent = row < MLAT; const float* xr = latent ? xlat + (size_t)row * D : xctx + (size_t)(row - MLAT) * D;
                const float* mv = modl + (latent ? (row >> 13) : 4) * 6144; const float* gp = norm1_g + l * D;
                f32x4 v[4]; float ss = 0.f;
#pragma unroll
                for (int j = 0; j < 4; ++j) { v[j] = *(const f32x4*)(xr + 256 * j + 4 * lane); ss += (v[j][0] * v[j][0] + v[j][1] * v[j][1]) + (v[j][2] * v[j][2] + v[j][3] * v[j][3]); }
                const float rinv = 1.0f / sqrtf(wave_sum(ss) * (1.0f / D) + NORM_EPS);
#pragma unroll
                for (int j = 0; j < 4; ++j) { const int c = 256 * j + 4 * lane; const f32x4 g = *(const f32x4*)(gp + c), sh = *(const f32x4*)(mv + c), sc = *(const f32x4*)(mv + 1024 + c);
                    const f32x4 y = (v[j] * rinv * g) * (1.0f + sc) + sh; u32x2 w; w.x = cvt_pk_bf16(y[0], y[1]); w.y = cvt_pk_bf16(y[2], y[3]); *(u32x2*)(H + (size_t)row * D + c) = w; }
            }
        }
        SEAM(P + 0);
        if (IN(P + 1)) {
            pg8::G1Sched S{(const char*)H, (const char*)(wl + WO_W1), NPAN, G, bx};
            pg8::EpiG1 E{QA, KA, VAT, QB, U, CGB, KB, VBT, COS, SIN};
            pg8::gemm_phase<pg8::EpiG1, pg8::G1Sched>(lds + RING_OFF, S, E);
        }
        SEAM(P + 1);
        if (IN(P + 2)) {
            PHASE_IDS();
            AttnPtrs AP{QA, KA, VAT, QB, KB, VBT, CT, sw_sink};
            for (int t = gw; t < NBATCH * 8 * 256; t += NGW) { const int bh = t >> 8, r = (t >> 1) & 127, half = t & 1; na_task(AP, l, bh >> 3, bh & 7, r, half, lane); }
            for (int t = gw; t < NBATCH * 8 * 256; t += NGW) { const int bh = t >> 8, qblk = t & 255; swa_task(AP, l, bh >> 3, bh & 7, qblk, lane); }
            if (!lastl) for (int t = gw; t < 2 * NBATCH * 8 * 8; t += NGW) { const int typ = t >> 8, bh = (t >> 3) & 31, qblk = t & 7; ctx_task(AP, l, typ, bh >> 3, bh & 7, qblk, lane); }
            const int nrows = lastl ? MLAT : MT;
            const float* cw = conv_w + (size_t)l * 3 * 512;
            for (int it = gw * 64 + lane; it < nrows * 64; it += NGW * 64) {
                const int row = it >> 6, ch = (it & 63) * 8;
                const bool latent = row < MLAT; const int tl = latent ? (row & (SEQ - 1)) : ((row - MLAT) & (CTXL - 1)); const int tmax = latent ? SEQ - 1 : CTXL - 1;
                const u32x4 zero = {0u, 0u, 0u, 0u};
                const u32x4 um = (tl > 0) ? *(const u32x4*)(U + (size_t)(row - 1) * 512 + ch) : zero;
                const u32x4 uc = *(const u32x4*)(U + (size_t)row * 512 + ch);
                const u32x4 up = (tl < tmax) ? *(const u32x4*)(U + (size_t)(row + 1) * 512 + ch) : zero;
                const u32x4 gb = *(const u32x4*)(CGB + (size_t)row * 512 + ch);
                f32x4 m0, m1, c0, c1, p0, p1, g0, g1; unpack8(um, m0, m1); unpack8(uc, c0, c1); unpack8(up, p0, p1); unpack8(gb, g0, g1);
                const f32x4 w00 = *(const f32x4*)(cw + ch), w01 = *(const f32x4*)(cw + ch + 4), w10 = *(const f32x4*)(cw + 512 + ch), w11 = *(const f32x4*)(cw + 512 + ch + 4), w20 = *(const f32x4*)(cw + 1024 + ch), w21 = *(const f32x4*)(cw + 1024 + ch + 4);
                const f32x4 y0 = g0 * (w00 * m0 + w10 * c0 + w20 * p0), y1 = g1 * (w01 * m1 + w11 * c1 + w21 * p1);
                *(u32x4*)(CGB + (size_t)row * 512 + ch) = pack8(y0, y1);
            }
        }
        SEAM(P + 2);
        const int nMl = lastl ? NPAN_LAT : NPAN;
        if (IN(P + 3)) {
            pg8::G2Sched S{(const char*)H, (const char*)(wl + WO_W1), (const char*)QA, (const char*)(wl + WO_WBR), nMl, G, bx};
            u32x4* scrg = (u32x4*)(ws + WS_SCR + (size_t)bx * 262144);
            pg8::EpiG2 E{scrg, scrg + 8192, MERGED, b_gate + (size_t)l * 3072};
            pg8::gemm_phase<pg8::EpiG2, pg8::G2Sched>(lds + RING_OFF, S, E);
        }
        SEAM(P + 3);
        if (IN(P + 4)) {
            pg8::SimpleSched S{(const char*)MERGED, (const char*)(wl + WO_WO), 2048, 2048, 16, nMl, 4, G, bx};
            pg8::EpiRes E{xlat, xctx, out, XC, modl, 2048};
            pg8::gemm_phase<pg8::EpiRes, pg8::SimpleSched>(lds + RING_OFF, S, E);
        }
        SEAM(P + 4);
        if (IN(P + 5)) {
            PHASE_IDS();
            const int nrows = lastl ? MLAT : MT;
            for (int row = gw; row < nrows; row += NGW) {
                const bool latent = row < MLAT; const float* xr = latent ? out + (size_t)row * D : XC + (size_t)(row - MLAT) * D;
                const float* mv = modl + (latent ? (row >> 13) : 4) * 6144 + 3072; const float* gp = norm2_g + l * D;
                f32x4 v[4]; float ss = 0.f;
#pragma unroll
                for (int j = 0; j < 4; ++j) { v[j] = *(const f32x4*)(xr + 256 * j + 4 * lane); ss += (v[j][0] * v[j][0] + v[j][1] * v[j][1]) + (v[j][2] * v[j][2] + v[j][3] * v[j][3]); }
                const float rinv = 1.0f / sqrtf(wave_sum(ss) * (1.0f / D) + NORM_EPS);
#pragma unroll
                for (int j = 0; j < 4; ++j) { const int c = 256 * j + 4 * lane; const f32x4 g = *(const f32x4*)(gp + c), sh = *(const f32x4*)(mv + c), sc = *(const f32x4*)(mv + 1024 + c);
                    const f32x4 y = (v[j] * rinv * g) * (1.0f + sc) + sh; u32x2 w; w.x = cvt_pk_bf16(y[0], y[1]); w.y = cvt_pk_bf16(y[2], y[3]); *(u32x2*)(H + (size_t)row * D + c) = w; }
            }
        }
        SEAM(P + 5);
        if (IN(P + 6)) {
            pg8::SimpleSched S{(const char*)H, (const char*)(wl + WO_W4), 2048, 2048, 16, nMl, 22, G, bx};
            pg8::EpiSwiglu E{ACT};
            pg8::gemm_phase<pg8::EpiSwiglu, pg8::SimpleSched>(lds + RING_OFF, S, E);
        }
        SEAM(P + 6);
        if (IN(P + 7)) {
            pg8::SimpleSched S{(const char*)ACT, (const char*)(wl + WO_W5), 2 * DFF, 2 * DFF, DFF / 64, nMl, 4, G, bx};
            pg8::EpiRes E{out, XC, out, XC, modl, 5120};
            pg8::gemm_phase<pg8::EpiRes, pg8::SimpleSched>(lds + RING_OFF, S, E);
        }
        SEAM(P + 7);
    }
    if (IN(NPHASE - 1)) {
        PHASE_IDS();
        for (int row = gw; row < MLAT; row += NGW) {
            float* xr = out + (size_t)row * D;
            f32x4 v[4]; float ss = 0.f;
#pragma unroll
            for (int j = 0; j < 4; ++j) { v[j] = *(const f32x4*)(xr + 256 * j + 4 * lane); ss += (v[j][0] * v[j][0] + v[j][1] * v[j][1]) + (v[j][2] * v[j][2] + v[j][3] * v[j][3]); }
            const float rinv = 1.0f / sqrtf(wave_sum(ss) * (1.0f / D) + NORM_EPS);
#pragma unroll
            for (int j = 0; j < 4; ++j) { const int c = 256 * j + 4 * lane; const f32x4 g = *(const f32x4*)(final_g + c); *(f32x4*)(xr + c) = v[j] * rinv * g; }
        }
    }
#undef IN
#undef SEAM
}

extern "C" void kernel_launch(void* const* d_in, const int* in_sizes, int n_in, void* d_out, int out_size, void* d_ws, size_t ws_size, hipStream_t stream) {
    static int grid = 0;
    if (grid == 0) {
        if (n_in != 20 || in_sizes[0] != MLAT * D || out_size != MLAT * D || ws_size < WS_END) {
            fprintf(stderr, "kernel_launch: unexpected shapes: n_in %d in0 %d out %d ws %zu (need %zu); nothing launched\n", n_in, n_in > 0 ? in_sizes[0] : -1, out_size, ws_size, (size_t)WS_END); grid = -1; return; }
        int dev = 0, cus = 0, per_cu = 0;
        if (hipGetDevice(&dev) != hipSuccess || hipDeviceGetAttribute(&cus, hipDeviceAttributeMultiprocessorCount, dev) != hipSuccess) { fprintf(stderr, "kernel_launch: device query failed\n"); grid = -1; return; }
        if (hipFuncSetAttribute((const void*)fwd_kernel, hipFuncAttributeMaxDynamicSharedMemorySize, LDS_BYTES) != hipSuccess) { fprintf(stderr, "kernel_launch: hipFuncSetAttribute failed\n"); grid = -1; return; }
        if (hipOccupancyMaxActiveBlocksPerMultiprocessor(&per_cu, (const void*)fwd_kernel, NWAVES * 64, LDS_BYTES) != hipSuccess || per_cu < 1)
            fprintf(stderr, "kernel_launch: note: occupancy query reports %d workgroups per CU\n", per_cu);
        (void)hipGetLastError();
        grid = cus > 256 ? 256 : cus;
    }
    if (grid < 0) return;
    if (hipMemsetAsync((char*)d_ws + WS_CTL, 0, CTL_ZERO_BYTES, stream) != hipSuccess) { fprintf(stderr, "kernel_launch: memset failed\n"); return; }
    Args a{};
    for (int i = 0; i < 20; ++i) a.in[i] = (const float*)d_in[i];
    a.out = (float*)d_out; a.ws = (unsigned char*)d_ws;
#if MK_SINGLE
    a.ph_lo = 0; a.ph_hi = NPHASE;
    hipLaunchKernelGGL(fwd_kernel, dim3(grid), dim3(NWAVES * 64), LDS_BYTES, stream, a);
#else
    for (int p = 0; p < NPHASE; ++p) { a.ph_lo = p; a.ph_hi = p + 1; hipLaunchKernelGGL(fwd_kernel, dim3(grid), dim3(NWAVES * 64), LDS_BYTES, stream, a); }
#endif
    const hipError_t le = hipPeekAtLastError();
    if (le != hipSuccess) fprintf(stderr, "kernel_launch: launch failed: %s\n", hipGetErrorName(le));
}
```

```cpp
#include <hip/hip_runtime.h>
#include <cstdio>
#include <cstdint>

#ifndef MK_SINGLE
#define MK_SINGLE 1
#endif

#ifndef PROBE_DUP
#define PROBE_DUP 0
#endif
#define GAS __attribute__((address_space(1)))
#define LAS __attribute__((address_space(3)))
typedef unsigned short bf16_t;
typedef short bf16x8 __attribute__((ext_vector_type(8)));
typedef float f32x4 __attribute__((ext_vector_type(4)));
typedef float f32x2 __attribute__((ext_vector_type(2)));
typedef float f32x16 __attribute__((ext_vector_type(16)));
typedef unsigned u32x4 __attribute__((ext_vector_type(4)));
typedef unsigned u32x2 __attribute__((ext_vector_type(2)));

constexpr int D = 1024, NBATCH = 4, SEQ = 8192, DEPTH = 4, CTXL = 256;
constexpr int MLAT = NBATCH * SEQ;
constexpr int MCTX = NBATCH * CTXL;
constexpr int MT = MLAT + MCTX;
constexpr int NPAN = MT / 256;
constexpr int NPAN_LAT = MLAT / 256;
constexpr int NIN = 6912, DFF = 2816;
constexpr float NORM_EPS = 1e-6f;
constexpr float LOG2E = 1.4426950408889634f;
constexpr float C2 = 0.125f * LOG2E;
constexpr float NEGBIG = -30000.0f;

constexpr size_t MiB = 1u << 20;
constexpr size_t WS_CTL = 0, CTL_ZERO_BYTES = 1 * MiB;
constexpr size_t WS_MOD = 1 * MiB;
constexpr size_t WS_COS = 2 * MiB, WS_SIN = 3 * MiB;
constexpr size_t WS_CT = 4 * MiB;
constexpr size_t WS_W = 12 * MiB;
constexpr size_t W_LAYER_ELEMS = 18350080;
constexpr size_t WO_W1 = 0, WO_WBR = 7077888, WO_WO = 8650752, WO_W4 = 9699328, WO_W5 = 15466496;
constexpr size_t WS_H = 152 * MiB;
constexpr size_t WS_XC = 218 * MiB;
constexpr size_t WS_Z = 222 * MiB;
constexpr size_t Z33 = 33 * MiB;
constexpr size_t WS_QA = WS_Z, WS_QB = WS_Z + Z33, WS_CGB = WS_Z + 2 * Z33, WS_KA = WS_Z + 3 * Z33, WS_VAT = WS_Z + 4 * Z33, WS_U = WS_Z + 5 * Z33;
constexpr size_t WS_KB = WS_Z + 6 * Z33, WS_VBT = WS_KB + (size_t)MT * 128 * 2;
constexpr size_t WS_MERGED = WS_KA;
constexpr size_t WS_ACT = WS_Z;
constexpr size_t WS_SCR = 437 * MiB;
constexpr size_t WS_END = 501 * MiB;
static_assert(WS_VBT + (size_t)MT * 128 * 2 <= WS_SCR, "ws map");
static_assert(WS_ACT + (size_t)MT * DFF * 2 <= WS_KB, "act overlay");
static_assert(WS_W + 4 * W_LAYER_ELEMS * 2 <= WS_H, "weights");

constexpr int CW_BAR = 4096;

constexpr int RING_OFF = 0, RING_BYTES = 131072;
constexpr int LDSCTL_OFF = RING_BYTES, MISC_OFF = LDSCTL_OFF + 320;
constexpr int LDS_BYTES = 147456;
constexpr int NWAVES = 8;

__device__ __forceinline__ unsigned cvt_pk_bf16(float lo, float hi) { unsigned r; asm volatile("v_cvt_pk_bf16_f32 %0, %1, %2" : "=v"(r) : "v"(lo), "v"(hi)); return r; }
__device__ __forceinline__ float bf_lo(unsigned w) { return __uint_as_float(w << 16); }
__device__ __forceinline__ float bf_hi(unsigned w) { return __uint_as_float(w & 0xffff0000u); }
__device__ __forceinline__ unsigned short f2bf(float f) { return (unsigned short)(cvt_pk_bf16(f, 0.f) & 0xffffu); }
__device__ __forceinline__ float fast_sigmoid(float x) { return __builtin_amdgcn_rcpf(1.0f + __builtin_amdgcn_exp2f(-x * LOG2E)); }
__device__ __forceinline__ u32x4 pack8(f32x4 a, f32x4 b) { u32x4 w; w.x = cvt_pk_bf16(a[0], a[1]); w.y = cvt_pk_bf16(a[2], a[3]); w.z = cvt_pk_bf16(b[0], b[1]); w.w = cvt_pk_bf16(b[2], b[3]); return w; }
__device__ __forceinline__ void unpack8(u32x4 w, f32x4& a, f32x4& b) { a[0] = bf_lo(w.x); a[1] = bf_hi(w.x); a[2] = bf_lo(w.y); a[3] = bf_hi(w.y); b[0] = bf_lo(w.z); b[1] = bf_hi(w.z); b[2] = bf_lo(w.w); b[3] = bf_hi(w.w); }
__device__ __forceinline__ float wave_sum(float v) {
#pragma unroll
    for (int o = 1; o < 64; o <<= 1) v += __shfl_xor(v, o);
    return v;
}
#define LDS_WAIT() asm volatile("s_waitcnt lgkmcnt(0)" ::: "memory")
__device__ __forceinline__ int opaque_tid() { int t = threadIdx.x; asm volatile("" : "+v"(t)); return t; }
typedef GAS bf16_t* gbf_p; typedef GAS float* gf32_p; typedef const GAS float* gcf32_p; typedef GAS u32x4* gu4_p;
#define OPAQUE_S(p) asm volatile("" : "+s"(p))

#define XB_TMO      128
#define XB_XCNT(j)  (256  + 64 * (j))
#define XB_XSUB(j)  (1280 + 64 * (j))
#define XB_XGEN(j)  (2304 + 64 * (j))
#define XB_TOP      3328
#define XB_TOPGEN   3392
#define XCD_BAR_WORDS 3456
#define XB_SPIN_CAP (1u << 18)
__device__ __forceinline__ unsigned xb_ld(unsigned* p)              { return __hip_atomic_load(p, __ATOMIC_RELAXED, __HIP_MEMORY_SCOPE_AGENT); }
__device__ __forceinline__ unsigned xb_add(unsigned* p, unsigned v) { return __hip_atomic_fetch_add(p, v, __ATOMIC_RELAXED, __HIP_MEMORY_SCOPE_AGENT); }
__device__ __forceinline__ unsigned xb_xcc_id() { return (unsigned)__builtin_amdgcn_s_getreg((3 << 11) | 20) & 0xFu; }
#define XB_SPIN(cond, bar) do { unsigned _sp = 0; while (cond) { __builtin_amdgcn_s_sleep(1); \
    if ((++_sp & 255u) == 0u) { if (xb_ld(&(bar)[XB_TMO])) break; if (_sp > XB_SPIN_CAP) { atomicAdd(&(bar)[XB_TMO], 1u); break; } } } } while (0)
struct XcdBarrier { unsigned* bar; unsigned x; volatile LAS unsigned* st; };
__device__ __forceinline__ XcdBarrier xcd_barrier_post(unsigned* bar, volatile LAS unsigned* st) {
    XcdBarrier b; b.bar = bar; b.x = xb_xcc_id(); b.st = st;
    if (threadIdx.x == 0) (void)xb_add(&bar[XB_XCNT(b.x)], 1u);
    return b;
}
__device__ __forceinline__ void xcd_barrier_complete(unsigned* bar, unsigned x, unsigned& nloc, unsigned& nx) {
    const unsigned G = gridDim.x * gridDim.y * gridDim.z;
    unsigned sum, cnt, mine, sp = 0u;
    for (;;) {
        sum = 0u; cnt = 0u; mine = 0u;
#pragma unroll
        for (unsigned j = 0; j < 16; ++j) { const unsigned c = xb_ld(&bar[XB_XCNT(j)]); sum += c; cnt += (c > 0u) ? 1u : 0u; mine = (j == x) ? c : mine; }
        if (sum == G) break;
        __builtin_amdgcn_s_sleep(1);
        if ((++sp & 255u) == 0u) { if (xb_ld(&bar[XB_TMO])) break; if (sp > XB_SPIN_CAP) { atomicAdd(&bar[XB_TMO], 1u); break; } }
    }
    nloc = mine > 0u ? mine : 1u; nx = cnt > 0u ? cnt : 1u;
}
__device__ __forceinline__ void xcd_barrier(const XcdBarrier& b) {
    asm volatile("s_waitcnt vmcnt(0)" ::: "memory");
    __syncthreads();
    if (threadIdx.x == 0) {
        unsigned* bar = b.bar;
        __builtin_amdgcn_s_waitcnt(0);
        unsigned nloc = b.st[0], nx = b.st[1];
        if (nloc == 0u) { xcd_barrier_complete(bar, b.x, nloc, nx); b.st[0] = nloc; b.st[1] = nx; }
        const unsigned old = xb_add(&bar[XB_XSUB(b.x)], 1u);
        const unsigned gen = old / nloc;
        if (old + 1u == (gen + 1u) * nloc) {
            __builtin_amdgcn_fence(__ATOMIC_RELEASE, "agent");
            asm volatile("s_waitcnt vmcnt(0)" ::: "memory");
            const unsigned og = xb_add(&bar[XB_TOP], 1u);
            const unsigned tg = og / nx;
            if (og + 1u == (tg + 1u) * nx) xb_add(&bar[XB_TOPGEN], 1u);
            else XB_SPIN(xb_ld(&bar[XB_TOPGEN]) == tg, bar);
            __builtin_amdgcn_fence(__ATOMIC_ACQUIRE, "agent");
            xb_add(&bar[XB_XGEN(b.x)], 1u);
            asm volatile("s_waitcnt vmcnt(0)" ::: "memory");
        } else {
            XB_SPIN(xb_ld(&bar[XB_XGEN(b.x)]) == gen, bar);
            __builtin_amdgcn_fence(__ATOMIC_ACQUIRE, "agent");
            asm volatile("s_waitcnt vmcnt(0)" ::: "memory");
        }
    }
    __syncthreads();
}

namespace pg8 {
constexpr int BM = 256, BK = 64, HALF = 128, HTB = HALF * BK * 2, STAGE_BYTES = 8 * HTB, NXCD = 8, WGM = 8;
__host__ __device__ __forceinline__ int lds_byte(int r, int c) { const int st = (r >> 4) * 2 + (c >> 5), rr = r & 15, cc = c & 31, ob = rr * 64 + cc * 2; return st * 1024 + (ob ^ (((ob >> 9) & 1) << 5)); }
__host__ __device__ __forceinline__ void stage_rc(int b, int& R, int& C) { const int st = b / 1024, sb = b % 1024, swz = sb ^ (((sb >> 9) & 1) << 5); R = (st >> 1) * 16 + swz / 64; C = (st & 1) * 32 + (swz % 64) / 2; }
__host__ __device__ __forceinline__ int perm32(int rho) { const int n = rho >> 4, i = rho & 15; return 8 * (i >> 2) + 4 * n + (i & 3); }

struct GUnit { const char* A; const char* B; unsigned lda2, ldb2; int nt; int pm, pn, mode; };

__device__ __forceinline__ bool tile_order(long L, int nM, int nN, int& pm, int& pn) {
    const int nwg = nM * nN; if (L >= nwg) return false;
    int wgid = (int)L; { const int q = nwg / NXCD, r = nwg % NXCD, xcd = wgid % NXCD, off = wgid / NXCD; wgid = (xcd < r ? xcd * (q + 1) : r * (q + 1) + (xcd - r) * q) + off; }
    const int nig = WGM * nN, gid = wgid / nig, fm = gid * WGM, gsz = (nM - fm) < WGM ? (nM - fm) : WGM;
    pm = fm + ((wgid % nig) % gsz); pn = (wgid % nig) / gsz; return true;
}

template <class Epi, class Sched>
__device__ __forceinline__ void gemm_phase(LAS unsigned char* lds, const Sched& S, const Epi& E) {
    const int tid = opaque_tid(), wid = __builtin_amdgcn_readfirstlane(tid >> 6), lane = tid & 63, wr = wid >> 2, wc = wid & 3, fr = lane & 15, fq = lane >> 4;
    unsigned sR[2], sRb[2], sC[2];
#pragma unroll
    for (int i = 0; i < 2; ++i) { int R, C; stage_rc(tid * 16 + i * 8192, R, C); sR[i] = (unsigned)R; sRb[i] = (unsigned)(Epi::PERM ? ((R & ~31) + perm32(R & 31)) : R); sC[i] = (unsigned)C * 2u; }
    const size_t kstep = (size_t)(BK * 2);
    const unsigned ldsw = (unsigned)wid * 1024u;
    const int aoff = lds_byte(wr * 64 + fr, fq * 8), boff = lds_byte(wc * 32 + fr, fq * 8);
#define PG8_SA(b, h) (((b) * 2 + (h)) * HTB)
#define PG8_SB(b, h) ((4 + (b) * 2 + (h)) * HTB)
#define PG8_STAGE(bufoff, gbase, voff) do { _Pragma("unroll") for (int _i = 0; _i < 2; ++_i) \
        __builtin_amdgcn_global_load_lds((const unsigned*)((const char*)(gbase) + (voff)[_i]), (LAS unsigned*)(lds + (bufoff) + ldsw + _i * 8192), 16, 0, 0); } while (0)
#define PG8_LDA(dst, b, h) do { _Pragma("unroll") for (int m = 0; m < 4; ++m) _Pragma("unroll") for (int k = 0; k < 2; ++k) dst[m][k] = *(const LAS bf16x8*)(lds + PG8_SA(b, h) + aoff + m * 2048 + k * 1024); } while (0)
#define PG8_LDB(dst, b, h) do { _Pragma("unroll") for (int n = 0; n < 2; ++n) _Pragma("unroll") for (int k = 0; k < 2; ++k) dst[n][k] = *(const LAS bf16x8*)(lds + PG8_SB(b, h) + boff + n * 2048 + k * 1024); } while (0)
#define PG8_MMA(ai, bj, At, Bt) do { __builtin_amdgcn_s_setprio(1); _Pragma("unroll") for (int m = 0; m < 4; ++m) _Pragma("unroll") for (int n = 0; n < 2; ++n) _Pragma("unroll") for (int k = 0; k < 2; ++k) \
        acc[ai][bj][m][n] = __builtin_amdgcn_mfma_f32_16x16x32_bf16(Bt[n][k], At[m][k], acc[ai][bj][m][n], 0, 0, 0); __builtin_amdgcn_s_setprio(0); } while (0)
#define PG8_WAIT_V(n) asm volatile("s_waitcnt vmcnt(" #n ")" ::: "memory")
#define PG8_WAIT_L(n) asm volatile("s_waitcnt lgkmcnt(" #n ")" ::: "memory")
#define PG8_BAR __builtin_amdgcn_s_barrier()
#define PG8_SCHED __builtin_amdgcn_sched_barrier(0)
#define PG8_VOFF(u, vA, vB) do { _Pragma("unroll") for (int _i = 0; _i < 2; ++_i) { vA[_i] = sR[_i] * (u).lda2 + sC[_i]; vB[_i] = sRb[_i] * (u).ldb2 + sC[_i]; } } while (0)
    GUnit cur, nxt; int ui = 0;
    if (!S.next(0, cur)) return;
    f32x4 acc[2][2][4][2];
#pragma unroll
    for (int a = 0; a < 2; ++a)
#pragma unroll
        for (int b = 0; b < 2; ++b)
#pragma unroll
            for (int m = 0; m < 4; ++m)
#pragma unroll
                for (int n = 0; n < 2; ++n) acc[a][b][m][n] = (f32x4){0.f, 0.f, 0.f, 0.f};
    bf16x8 At[4][2], B0[2][2], B1[2][2];
    unsigned vA[2], vB[2], nvA[2], nvB[2];
    PG8_VOFF(cur, vA, vB);
    const char* cA = cur.A; const char* cB = cur.B;
    size_t hA = (size_t)HALF * cur.lda2, hB = (size_t)HALF * cur.ldb2;
    PG8_STAGE(PG8_SB(0, 0), cB, vB); PG8_STAGE(PG8_SB(0, 1), cB + hB, vB); PG8_STAGE(PG8_SA(0, 0), cA, vA); PG8_STAGE(PG8_SA(0, 1), cA + hA, vA);
    if (wr == 1) PG8_BAR;
    PG8_WAIT_V(2); PG8_BAR;
    PG8_STAGE(PG8_SB(1, 0), cB + kstep, vB); PG8_STAGE(PG8_SA(1, 0), cA + kstep, vA); PG8_STAGE(PG8_SB(1, 1), cB + hB + kstep, vB);
    PG8_WAIT_V(6); PG8_BAR;
    for (;;) {
        const bool has_next = S.next(ui + 1, nxt);
        const char* nA = cA; const char* nB = cB; size_t nhA = hA, nhB = hB;
        nvA[0] = vA[0]; nvA[1] = vA[1]; nvB[0] = vB[0]; nvB[1] = vB[1];
        if (has_next) { nA = nxt.A; nB = nxt.B; nhA = (size_t)HALF * nxt.lda2; nhB = (size_t)HALF * nxt.ldb2; PG8_VOFF(nxt, nvA, nvB); }
        const int nt = cur.nt;
        for (int t = 0; t < nt; t += 2) {
            const bool last = (t == nt - 2);
            const char* a1 = cA + (size_t)(t + 1) * kstep;
            const char* a2 = last ? nA : cA + (size_t)(t + 2) * kstep; const char* b2 = last ? nB : cB + (size_t)(t + 2) * kstep;
            const char* a3 = a2 + kstep; const char* b3 = b2 + kstep;
            unsigned wA[2], wB[2]; wA[0] = last ? nvA[0] : vA[0]; wA[1] = last ? nvA[1] : vA[1]; wB[0] = last ? nvB[0] : vB[0]; wB[1] = last ? nvB[1] : vB[1];
            const size_t hA2 = last ? nhA : hA, hB2 = last ? nhB : hB;
            PG8_LDB(B0, 0, 0); PG8_LDB(B1, 0, 1); PG8_SCHED; PG8_LDA(At, 0, 0); PG8_STAGE(PG8_SA(1, 1), a1 + hA, vA);
            PG8_WAIT_V(8); PG8_WAIT_L(0); PG8_BAR; PG8_MMA(0, 0, At, B0); PG8_MMA(0, 1, At, B1); PG8_BAR; PG8_SCHED;
            PG8_LDA(At, 0, 1); PG8_STAGE(PG8_SB(0, 0), b2, wB); PG8_STAGE(PG8_SB(0, 1), b2 + hB2, wB); PG8_STAGE(PG8_SA(0, 0), a2, wA);
            PG8_WAIT_V(8); PG8_WAIT_L(0); PG8_BAR; PG8_MMA(1, 0, At, B0); PG8_MMA(1, 1, At, B1); PG8_BAR; PG8_SCHED;
            PG8_LDB(B0, 1, 0); PG8_LDB(B1, 1, 1); PG8_SCHED; PG8_LDA(At, 1, 0); PG8_STAGE(PG8_SA(0, 1), a2 + hA2, wA);
            PG8_WAIT_V(8); PG8_WAIT_L(0); PG8_BAR; PG8_MMA(0, 0, At, B0); PG8_MMA(0, 1, At, B1); PG8_BAR; PG8_SCHED;
            PG8_LDA(At, 1, 1); PG8_STAGE(PG8_SB(1, 0), b3, wB); PG8_STAGE(PG8_SB(1, 1), b3 + hB2, wB); PG8_STAGE(PG8_SA(1, 0), a3, wA);
            PG8_WAIT_V(8); PG8_WAIT_L(0); PG8_BAR; PG8_MMA(1, 0, At, B0); PG8_MMA(1, 1, At, B1); PG8_BAR; PG8_SCHED;
        }
        if (wr == 0) PG8_BAR;
        E(acc, cur, wr, wc, fr, fq);
        if (!has_next) break;
#pragma unroll
        for (int a = 0; a < 2; ++a)
#pragma unroll
            for (int b = 0; b < 2; ++b)
#pragma unroll
                for (int m = 0; m < 4; ++m)
#pragma unroll
                    for (int n = 0; n < 2; ++n) acc[a][b][m][n] = (f32x4){0.f, 0.f, 0.f, 0.f};
        cur = nxt; cA = nA; cB = nB; hA = nhA; hB = nhB; vA[0] = nvA[0]; vA[1] = nvA[1]; vB[0] = nvB[0]; vB[1] = nvB[1]; ++ui;
        if (wr == 1) PG8_BAR;
    }
    PG8_WAIT_V(0);
    PG8_BAR;
#undef PG8_SA
#undef PG8_SB
#undef PG8_STAGE
#undef PG8_LDA
#undef PG8_LDB
#undef PG8_MMA
#undef PG8_WAIT_V
#undef PG8_WAIT_L
#undef PG8_BAR
#undef PG8_SCHED
#undef PG8_VOFF
}

struct SimpleSched {
    const char* A; const char* B; unsigned lda2, ldb2; int nt, nM, nN, G, c;
    __device__ __forceinline__ bool next(int i, GUnit& u) const {
        int pm, pn; if (!tile_order((long)i * G + c, nM, nN, pm, pn)) return false;
        u.A = A + (size_t)pm * 256 * lda2; u.B = B + (size_t)pn * 256 * ldb2; u.lda2 = lda2; u.ldb2 = ldb2; u.nt = nt; u.pm = pm; u.pn = pn; u.mode = 0; return true;
    }
};
struct G1Sched {
    const char* H; const char* W1; int nM, G, c;
    __device__ __forceinline__ bool next(int i, GUnit& u) const {
        int pm, pn; if (!tile_order((long)i * G + c, nM, 15, pm, pn)) return false;
        const char* hp = H + (size_t)pm * 256 * 2048;
        if (pn < 13) { u.A = hp; u.B = W1 + (size_t)pn * 256 * 2048; } else { u.A = W1 + (size_t)(3328 + (pn - 13) * 256) * 2048; u.B = hp; }
        u.lda2 = 2048; u.ldb2 = 2048; u.nt = 16; u.pm = pm; u.pn = pn; u.mode = 0; return true;
    }
};
struct G2Sched {
    const char* H; const char* W1; const char* OA; const char* WBR; int nM, G, c;
    __device__ __forceinline__ bool next(int i, GUnit& u) const {
        const int tile = i / 6, sub = i - tile * 6, br = sub >> 1;
        int pm, pn; if (!tile_order((long)tile * G + c, nM, 4, pm, pn)) return false;
        if ((sub & 1) == 0) { u.A = H + (size_t)pm * 256 * 2048; u.B = W1 + (size_t)(3840 + br * 1024 + pn * 256) * 2048; u.lda2 = 2048; u.ldb2 = 2048; u.nt = 16; }
        else { u.A = OA + (size_t)br * Z33 + (size_t)pm * 256 * 1024; u.B = WBR + (size_t)(br * 1024 + pn * 256) * 1024; u.lda2 = 1024; u.ldb2 = 1024; u.nt = 8; }
        u.pm = pm; u.pn = pn; u.mode = sub; return true;
    }
};

struct EpiG1 {
    static constexpr bool PERM = true;
    bf16_t *QA, *KA, *VAT, *QB, *U, *CGB, *KB, *VBT; const float *COS, *SIN;
    __device__ __forceinline__ void operator()(const f32x4 (&acc)[2][2][4][2], const GUnit& u, int wr, int wc, int fr, int fq) const {
        const int pn = u.pn;
        const int row0 = u.pm * 256 + wr * 64 + fr;
        const bool latent = u.pm < NPAN_LAT;
        if (pn == 2 || pn == 3) {
            bf16_t* base = KA; OPAQUE_S(base);
            gbf_p lp = (gbf_p)base + (size_t)(row0 >> 3) * 512 + (row0 & 7) * 8 + (fq & 1) * 64;
#pragma unroll
            for (int bj = 0; bj < 2; ++bj) { const int col = (pn - 2) * 256 + bj * 128 + wc * 32 + 8 * fq; const size_t ho = (size_t)(col >> 6) * MT * 64 + ((col >> 4) & 3) * 128;
#pragma unroll
                for (int ai = 0; ai < 2; ++ai)
#pragma unroll
                    for (int m = 0; m < 4; ++m) *(GAS u32x4*)(lp + ho + (ai * 128 + m * 16) * 64) = pack8(acc[ai][bj][m][0], acc[ai][bj][m][1]); }
        } else if (pn < 2 || pn == 10 || pn == 11) {
            bf16_t* base; float sc = 1.f; int colt;
            if (pn < 2) { base = QA; sc = C2; colt = pn * 256; } else { base = CGB; colt = (pn - 10) * 256; }
            OPAQUE_S(base);
            gbf_p lp = (gbf_p)base + (size_t)row0 * 512 + colt + wc * 32 + 8 * fq;
#pragma unroll
            for (int ai = 0; ai < 2; ++ai)
#pragma unroll
                for (int m = 0; m < 4; ++m)
#pragma unroll
                    for (int bj = 0; bj < 2; ++bj) *(GAS u32x4*)(lp + (ai * 128 + m * 16) * 512 + bj * 128) = pack8(acc[ai][bj][m][0] * sc, acc[ai][bj][m][1] * sc);
        } else if (pn < 6 || (pn == 12 && wc < 2)) {
            const bool isq = pn < 6;
            bf16_t* base = isq ? QB : KB; const int ld = isq ? 512 : 128; const int head = isq ? (pn - 4) * 4 + wc : wc; const float sc = isq ? C2 : 1.f;
            const float* cosb = COS; const float* sinb = SIN; OPAQUE_S(base); OPAQUE_S(cosb); OPAQUE_S(sinb);
            gbf_p lp = isq ? (gbf_p)base + (size_t)row0 * ld + head * 64 + 8 * fq
                           : (gbf_p)base + (size_t)head * MT * 64 + (size_t)(row0 >> 3) * 512 + (row0 & 7) * 8 + (fq >> 1) * 128 + (fq & 1) * 64;
            const int t0 = ((u.pm & 31) * 256 + wr * 64 + fr) * 32 + 8 * fq;
            gcf32_p cl = (gcf32_p)cosb + t0; gcf32_p sl = (gcf32_p)sinb + t0;
#pragma unroll
            for (int ai = 0; ai < 2; ++ai)
#pragma unroll
                for (int m = 0; m < 4; ++m) {
                    f32x4 x1a = acc[ai][0][m][0], x1b = acc[ai][0][m][1], x2a = acc[ai][1][m][0], x2b = acc[ai][1][m][1];
                    f32x4 o1a = x1a, o1b = x1b, o2a = x2a, o2b = x2b;
                    if (latent) { gcf32_p cp = cl + (ai * 128 + m * 16) * 32; gcf32_p sp = sl + (ai * 128 + m * 16) * 32;
                        const f32x4 ca = *(const GAS f32x4*)cp, cb = *(const GAS f32x4*)(cp + 4), sa = *(const GAS f32x4*)sp, sb = *(const GAS f32x4*)(sp + 4);
                        o1a = x1a * ca - x2a * sa; o1b = x1b * cb - x2b * sb; o2a = x1a * sa + x2a * ca; o2b = x1b * sb + x2b * cb; }
                    gbf_p rowp = lp + (size_t)(ai * 128 + m * 16) * (isq ? ld : 64);
                    *(GAS u32x4*)(rowp) = pack8(o1a * sc, o1b * sc); *(GAS u32x4*)(rowp + (isq ? 32 : 256)) = pack8(o2a * sc, o2b * sc); asm volatile("" ::: "memory"); }
        } else if (pn < 10) {
            bf16_t* ub = U; OPAQUE_S(ub);
            gbf_p lp = (gbf_p)ub + (size_t)row0 * 512 + (pn - 6) * 128 + wc * 32 + 8 * fq;
#pragma unroll
            for (int ai = 0; ai < 2; ++ai)
#pragma unroll
                for (int m = 0; m < 4; ++m) *(GAS u32x4*)(lp + (ai * 128 + m * 16) * 512) = pack8(acc[ai][0][m][0] * acc[ai][1][m][0], acc[ai][0][m][1] * acc[ai][1][m][1]);
        } else if (pn == 12) {
            bf16_t* vbt = VBT; OPAQUE_S(vbt);
            gbf_p lp = (gbf_p)vbt + (size_t)(row0 >> 3) * 512 + ((wc - 2) * 32 + 8 * fq) * 8 + (row0 & 7);
#pragma unroll
            for (int ai = 0; ai < 2; ++ai)
#pragma unroll
                for (int m = 0; m < 4; ++m)
#pragma unroll
                    for (int bj = 0; bj < 2; ++bj)
#pragma unroll
                        for (int n = 0; n < 2; ++n)
#pragma unroll
                            for (int e = 0; e < 4; ++e) lp[(size_t)bj * MT * 64 + (4 * n + e) * 8 + (ai * 128 + m * 16) * 64] = f2bf(acc[ai][bj][m][n][e]);
        } else {
            bf16_t* vat = VAT; OPAQUE_S(vat);
            const int f0 = (pn - 13) * 256 + wr * 64 + fr;
            gbf_p lp = (gbf_p)vat + (size_t)(f0 >> 6) * MT * 64 + (f0 & 63) * 8 + (size_t)(u.pm * 32 + wc * 4 + fq) * 512;
#pragma unroll
            for (int ai = 0; ai < 2; ++ai)
#pragma unroll
                for (int m = 0; m < 4; ++m)
#pragma unroll
                    for (int bj = 0; bj < 2; ++bj) *(GAS u32x4*)(lp + (size_t)(ai * 2) * MT * 64 + m * 128 + bj * 16 * 512) = pack8(acc[ai][bj][m][0], acc[ai][bj][m][1]);
        }
    }
};
struct EpiG2 {
    static constexpr bool PERM = true;
    u32x4* SG; u32x4* ST; bf16_t* MERGED; const float* bgate;
    __device__ __forceinline__ void operator()(const f32x4 (&acc)[2][2][4][2], const GUnit& u, int wr, int wc, int fr, int fq) const {
        const int sub = u.mode, br = sub >> 1, tid = (wr * 4 + wc) * 64 + fq * 16 + fr;
        u32x4* sg = SG; u32x4* st = ST; bf16_t* mg = MERGED; const float* bg = bgate; OPAQUE_S(sg); OPAQUE_S(st); OPAQUE_S(mg); OPAQUE_S(bg);
        gu4_p sgl = (gu4_p)sg + tid; gu4_p stl = (gu4_p)st + tid;
        if ((sub & 1) == 0) {
            gcf32_p bl = (gcf32_p)bg + br * 1024 + u.pn * 256 + wc * 32 + 8 * fq;
            f32x4 bv[2][2];
#pragma unroll
            for (int bj = 0; bj < 2; ++bj)
#pragma unroll
                for (int n = 0; n < 2; ++n) bv[bj][n] = *(const GAS f32x4*)(bl + bj * 128 + 4 * n);
#pragma unroll
            for (int ai = 0; ai < 2; ++ai)
#pragma unroll
                for (int bj = 0; bj < 2; ++bj)
#pragma unroll
                    for (int m = 0; m < 4; ++m) { f32x4 g0 = acc[ai][bj][m][0] + bv[bj][0], g1 = acc[ai][bj][m][1] + bv[bj][1];
#pragma unroll
                        for (int e = 0; e < 4; ++e) { g0[e] = fast_sigmoid(g0[e]); g1[e] = fast_sigmoid(g1[e]); }
                        sgl[((ai * 2 + bj) * 4 + m) * 512] = pack8(g0, g1); }
        } else {
            gbf_p lp = (gbf_p)mg + (size_t)(u.pm * 256 + wr * 64 + fr) * 1024 + u.pn * 256 + wc * 32 + 8 * fq;
#pragma unroll
            for (int ai = 0; ai < 2; ++ai)
#pragma unroll
                for (int bj = 0; bj < 2; ++bj)
#pragma unroll
                    for (int m = 0; m < 4; ++m) { const int k16 = ((ai * 2 + bj) * 4 + m) * 512;
                        f32x4 g0, g1; unpack8(sgl[k16], g0, g1);
                        f32x4 v0 = g0 * acc[ai][bj][m][0], v1 = g1 * acc[ai][bj][m][1];
                        if (br > 0) { f32x4 t0, t1; unpack8(stl[k16], t0, t1); v0 += t0; v1 += t1; }
                        const u32x4 w = pack8(v0, v1);
                        if (br < 2) stl[k16] = w;
                        else *(GAS u32x4*)(lp + (ai * 128 + m * 16) * 1024 + bj * 128) = w;
                        asm volatile("" ::: "memory"); }
        }
    }
};
struct EpiRes {
    static constexpr bool PERM = false;
    const float* base_lat; const float* base_ctx; float* out_lat; float* out_ctx; const float* mod; int goff;
    __device__ __forceinline__ void operator()(const f32x4 (&acc)[2][2][4][2], const GUnit& u, int wr, int wc, int fr, int fq) const {
        const bool latent = u.pm < NPAN_LAT;
        const int prow = latent ? u.pm : u.pm - NPAN_LAT;
        const float* base = latent ? base_lat : base_ctx; float* out = latent ? out_lat : out_ctx;
        const int bidx = latent ? (u.pm >> 5) : 4;
        const float* gv = mod + bidx * 6144 + goff;
        OPAQUE_S(base); OPAQUE_S(out); OPAQUE_S(gv);
        const int col0 = u.pn * 256 + wc * 32 + 4 * fq;
        const size_t off0 = (size_t)(prow * 256 + wr * 64 + fr) * 1024 + col0;
        gcf32_p bl = (gcf32_p)base + off0; gf32_p ol = (gf32_p)out + off0; gcf32_p gl = (gcf32_p)gv + col0;
        f32x4 g[2][2];
#pragma unroll
        for (int bj = 0; bj < 2; ++bj)
#pragma unroll
            for (int n = 0; n < 2; ++n) g[bj][n] = *(const GAS f32x4*)(gl + bj * 128 + n * 16);
#pragma unroll
        for (int ai = 0; ai < 2; ++ai)
#pragma unroll
            for (int m = 0; m < 4; ++m) {
#pragma unroll
                for (int bj = 0; bj < 2; ++bj)
#pragma unroll
                    for (int n = 0; n < 2; ++n) { const int o = (ai * 128 + m * 16) * 1024 + bj * 128 + n * 16; const f32x4 b = *(const GAS f32x4*)(bl + o); *(GAS f32x4*)(ol + o) = b + g[bj][n] * acc[ai][bj][m][n]; }
                if (m & 1) asm volatile("" ::: "memory"); }
    }
};
struct EpiSwiglu {
    static constexpr bool PERM = true;
    bf16_t* ACT;
    __device__ __forceinline__ void operator()(const f32x4 (&acc)[2][2][4][2], const GUnit& u, int wr, int wc, int fr, int fq) const {
        bf16_t* actb = ACT; OPAQUE_S(actb);
        gbf_p lp = (gbf_p)actb + (size_t)(u.pm * 256 + wr * 64 + fr) * DFF + u.pn * 128 + wc * 32 + 8 * fq;
#pragma unroll
        for (int ai = 0; ai < 2; ++ai)
#pragma unroll
            for (int m = 0; m < 4; ++m) { f32x4 a0 = acc[ai][0][m][0], a1 = acc[ai][0][m][1];
#pragma unroll
                for (int e = 0; e < 4; ++e) { a0[e] = a0[e] * fast_sigmoid(a0[e]); a1[e] = a1[e] * fast_sigmoid(a1[e]); }
                *(GAS u32x4*)(lp + (ai * 128 + m * 16) * DFF) = pack8(a0 * acc[ai][1][m][0], a1 * acc[ai][1][m][1]); }
    }
};
}

__device__ __forceinline__ int pi32(int m) { return (m & ~12) | ((m & 4) << 1) | ((m & 8) >> 1); }
struct KVF { bf16x8 k[4]; bf16x8 v[4]; };
__device__ __forceinline__ void kv_load(KVF& f, const bf16_t* Kt, const bf16_t* Vt, size_t key0, int koffl, int voffl) {
    const bf16_t* kp = Kt + (key0 >> 3) * 512 + koffl;
#pragma unroll
    for (int d0 = 0; d0 < 4; ++d0) f.k[d0] = *(const bf16x8*)(kp + 128 * d0);
    const bf16_t* vp = Vt + (key0 >> 3) * 512 + voffl;
    f.v[0] = *(const bf16x8*)(vp); f.v[1] = *(const bf16x8*)(vp + 1024); f.v[2] = *(const bf16x8*)(vp + 256); f.v[3] = *(const bf16x8*)(vp + 1280);
}
constexpr float RESC_THR = 8.0f;
__device__ __forceinline__ void attn_compute(const KVF& f, const bf16x8 (&qf)[4], f32x16 s, int maskmode, int r32, int hi, f32x16& o0, f32x16& o1, float& m, float& l) {
#pragma unroll
    for (int d0 = 0; d0 < 4; ++d0) s = __builtin_amdgcn_mfma_f32_32x32x16_bf16(f.k[d0], qf[d0], s, 0, 0, 0);
    if (maskmode != 0) {
#pragma unroll
        for (int r = 0; r < 16; ++r) { const int koff = 16 * (r >> 3) + 8 * hi + (r & 7); const bool ok = (maskmode == 1) ? (koff >= r32) : (koff <= r32); s[r] = ok ? s[r] : NEGBIG; }
    }
    float bm = fmaxf(fmaxf(s[0], s[1]), s[2]);
#pragma unroll
    for (int r = 3; r < 15; r += 2) bm = fmaxf(fmaxf(bm, s[r]), s[r + 1]);
    bm = fmaxf(bm, s[15]);
    bm = fmaxf(bm, __shfl_xor(bm, 32));
    if (__any(bm > m + RESC_THR)) {
        const float mn = fmaxf(m, bm);
        const float alpha = __builtin_amdgcn_exp2f(m - mn);
        m = mn; l *= alpha;
#pragma unroll
        for (int r = 0; r < 16; ++r) { o0[r] *= alpha; o1[r] *= alpha; }
    }
    float ps = 0.f;
#pragma unroll
    for (int r = 0; r < 16; ++r) { s[r] = __builtin_amdgcn_exp2f(s[r] - m); ps += s[r]; }
    l += ps;
    u32x4 w0, w1;
    w0.x = cvt_pk_bf16(s[0], s[1]); w0.y = cvt_pk_bf16(s[2], s[3]); w0.z = cvt_pk_bf16(s[4], s[5]); w0.w = cvt_pk_bf16(s[6], s[7]);
    w1.x = cvt_pk_bf16(s[8], s[9]); w1.y = cvt_pk_bf16(s[10], s[11]); w1.z = cvt_pk_bf16(s[12], s[13]); w1.w = cvt_pk_bf16(s[14], s[15]);
    const bf16x8 p0 = __builtin_bit_cast(bf16x8, w0), p1 = __builtin_bit_cast(bf16x8, w1);
    o0 = __builtin_amdgcn_mfma_f32_32x32x16_bf16(f.v[0], p0, o0, 0, 0, 0);
    o0 = __builtin_amdgcn_mfma_f32_32x32x16_bf16(f.v[1], p1, o0, 0, 0, 0);
    o1 = __builtin_amdgcn_mfma_f32_32x32x16_bf16(f.v[2], p0, o1, 0, 0, 0);
    o1 = __builtin_amdgcn_mfma_f32_32x32x16_bf16(f.v[3], p1, o1, 0, 0, 0);
}
__device__ __forceinline__ void attn_finish(bf16_t* orow, const f32x16& o0, const f32x16& o1, float l, int hi) {
    const float lt = l + __shfl_xor(l, 32);
    const float inv = 1.0f / lt;
#pragma unroll
    for (int g = 0; g < 4; ++g) {
        u32x2 a, b;
        a.x = cvt_pk_bf16(o0[4 * g] * inv, o0[4 * g + 1] * inv); a.y = cvt_pk_bf16(o0[4 * g + 2] * inv, o0[4 * g + 3] * inv);
        b.x = cvt_pk_bf16(o1[4 * g] * inv, o1[4 * g + 1] * inv); b.y = cvt_pk_bf16(o1[4 * g + 2] * inv, o1[4 * g + 3] * inv);
        *(u32x2*)(orow + 8 * g + 4 * hi) = a; *(u32x2*)(orow + 32 + 8 * g + 4 * hi) = b;
    }
}
__device__ __forceinline__ f32x16 zero16() { f32x16 z;
#pragma unroll
    for (int r = 0; r < 16; ++r) z[r] = 0.f;
    return z; }
__device__ __forceinline__ f32x16 load16(const float* p) { const f32x4 a = *(const f32x4*)p, b = *(const f32x4*)(p + 256), c = *(const f32x4*)(p + 512), d = *(const f32x4*)(p + 768);
    f32x16 z; z[0] = a[0]; z[1] = a[1]; z[2] = a[2]; z[3] = a[3]; z[4] = b[0]; z[5] = b[1]; z[6] = b[2]; z[7] = b[3]; z[8] = c[0]; z[9] = c[1]; z[10] = c[2]; z[11] = c[3]; z[12] = d[0]; z[13] = d[1]; z[14] = d[2]; z[15] = d[3]; return z; }

__device__ __forceinline__ void attn_ctx_blocks(const bf16_t* Kt, const bf16_t* Vt, size_t key0, const bf16x8 (&qf)[4], int koffl, int voffl, int r32, int hi, f32x16& o0, f32x16& o1, float& m, float& l) {
    KVF fa, fb;
    kv_load(fa, Kt, Vt, key0, koffl, voffl);
#pragma unroll 1
    for (int kb = 0; kb < 8; kb += 2) {
        kv_load(fb, Kt, Vt, key0 + (kb + 1) * 32, koffl, voffl);
        attn_compute(fa, qf, zero16(), 0, r32, hi, o0, o1, m, l);
        if (kb + 2 < 8) kv_load(fa, Kt, Vt, key0 + (kb + 2) * 32, koffl, voffl);
        attn_compute(fb, qf, zero16(), 0, r32, hi, o0, o1, m, l);
    }
}
struct AttnPtrs { bf16_t* QA; const bf16_t* KA; const bf16_t* VAT; bf16_t* QB; const bf16_t* KB; const bf16_t* VBT; const float* CT; const float* sink; };
#define ATTN_LANE() const int r32 = lane & 31, hi = lane >> 5; const int kp_ = pi32(r32); const int koffl = (kp_ >> 3) * 512 + hi * 64 + (kp_ & 7) * 8, voffl = hi * 512 + r32 * 8

__device__ __forceinline__ void na_task(const AttnPtrs& P, int l, int b, int h, int r, int half, int lane, bf16_t* oalt) {
    ATTN_LANE();
    const size_t qrow = (size_t)b * SEQ + r * 64 + half * 32 + r32;
    bf16_t* qp = P.QA + qrow * 512 + h * 64;
    bf16x8 qf[4];
#pragma unroll
    for (int d0 = 0; d0 < 4; ++d0) qf[d0] = *(const bf16x8*)(qp + d0 * 16 + hi * 8);
    f32x16 o0 = zero16(), o1 = zero16(); float m = -1e30f, lsum = 0.f;
    const bf16_t* Kh = P.KA + (size_t)h * MT * 64; const bf16_t* Vh = P.VAT + (size_t)h * MT * 64;
    attn_ctx_blocks(Kh, Vh, (size_t)(MLAT + b * CTXL), qf, koffl, voffl, r32, hi, o0, o1, m, lsum);
    const int r0 = min(max(r - 4, 0), 120);
    const float* ctb = P.CT + ((size_t)((l * 8 + h) * 15 + (r0 - r + 7)) * 4 + half * 2) * 1024 + lane * 4;
    const size_t key00 = (size_t)b * SEQ + r0 * 64;
    KVF fa, fb; f32x16 ca, cb;
    kv_load(fa, Kh, Vh, key00, koffl, voffl); ca = load16(ctb);
#pragma unroll 1
    for (int j = 0; j < 16; j += 2) {
        kv_load(fb, Kh, Vh, key00 + (j + 1) * 32, koffl, voffl); cb = load16(ctb + (size_t)((j >> 1) * 4 + 1) * 1024);
        attn_compute(fa, qf, ca, 0, r32, hi, o0, o1, m, lsum);
        if (j + 2 < 16) { kv_load(fa, Kh, Vh, key00 + (j + 2) * 32, koffl, voffl); ca = load16(ctb + (size_t)(((j + 2) >> 1) * 4) * 1024); }
        attn_compute(fb, qf, cb, 0, r32, hi, o0, o1, m, lsum);
    }
    attn_finish(oalt ? oalt + qrow * 512 + h * 64 : qp, o0, o1, lsum, hi);
}
__device__ __forceinline__ void swa_task(const AttnPtrs& P, int l, int b, int h, int qblk, int lane, bf16_t* oalt) {
    ATTN_LANE();
    const int g = h >> 2;
    const size_t qrow = (size_t)b * SEQ + qblk * 32 + r32;
    bf16_t* qp = P.QB + qrow * 512 + h * 64;
    bf16x8 qf[4];
#pragma unroll
    for (int d0 = 0; d0 < 4; ++d0) qf[d0] = *(const bf16x8*)(qp + d0 * 16 + hi * 8);
    f32x16 o0 = zero16(), o1 = zero16(); float m = P.sink[l * 8 + h] * LOG2E, lsum = (hi == 0) ? 1.f : 0.f;
    const bf16_t* Kh = P.KB + (size_t)g * MT * 64; const bf16_t* Vh = P.VBT + (size_t)g * MT * 64;
    attn_ctx_blocks(Kh, Vh, (size_t)(MLAT + b * CTXL), qf, koffl, voffl, r32, hi, o0, o1, m, lsum);
    const int jlo = (qblk < 4) ? (4 - qblk) : 0, jhi = (qblk > 251) ? (255 - qblk + 4) : 8;
    const int kb0 = b * SEQ + (qblk - 4) * 32;
    KVF fa, fb;
    kv_load(fa, Kh, Vh, (size_t)(kb0 + jlo * 32), koffl, voffl);
#pragma unroll 1
    for (int j = jlo; j <= jhi; j += 2) {
        if (j + 1 <= jhi) kv_load(fb, Kh, Vh, (size_t)(kb0 + (j + 1) * 32), koffl, voffl);
        attn_compute(fa, qf, zero16(), (j == 0) ? 1 : ((j == 8) ? 2 : 0), r32, hi, o0, o1, m, lsum);
        if (j + 2 <= jhi) kv_load(fa, Kh, Vh, (size_t)(kb0 + (j + 2) * 32), koffl, voffl);
        if (j + 1 <= jhi) attn_compute(fb, qf, zero16(), (j + 1 == 8) ? 2 : 0, r32, hi, o0, o1, m, lsum);
    }
    attn_finish(oalt ? oalt + qrow * 512 + h * 64 : qp, o0, o1, lsum, hi);
}
__device__ __forceinline__ void ctx_task(const AttnPtrs& P, int l, int typ, int b, int h, int qblk, int lane, bf16_t* oalt) {
    ATTN_LANE();
    const size_t qrow = (size_t)MLAT + b * CTXL + qblk * 32 + r32;
    bf16_t* qp = (typ == 0 ? P.QA : P.QB) + qrow * 512 + h * 64;
    bf16x8 qf[4];
#pragma unroll
    for (int d0 = 0; d0 < 4; ++d0) qf[d0] = *(const bf16x8*)(qp + d0 * 16 + hi * 8);
    f32x16 o0 = zero16(), o1 = zero16(); float m, lsum;
    if (typ == 0) { m = -1e30f; lsum = 0.f;
        attn_ctx_blocks(P.KA + (size_t)h * MT * 64, P.VAT + (size_t)h * MT * 64, (size_t)(MLAT + b * CTXL), qf, koffl, voffl, r32, hi, o0, o1, m, lsum); }
    else { const int g = h >> 2; m = P.sink[l * 8 + h] * LOG2E; lsum = (hi == 0) ? 1.f : 0.f;
        attn_ctx_blocks(P.KB + (size_t)g * MT * 64, P.VBT + (size_t)g * MT * 64, (size_t)(MLAT + b * CTXL), qf, koffl, voffl, r32, hi, o0, o1, m, lsum); }
    attn_finish(oalt ? oalt + qrow * 512 + h * 64 : qp, o0, o1, lsum, hi);
}

__device__ __forceinline__ void transpose_item(const float* W, int K, int N, bf16_t* WT, int ncol0, int nrow0, int k0, LAS float* scr, int lane) {
#pragma unroll 8
    for (int i = 0; i < 32; ++i) { const int kk = 2 * i + (lane >> 5); scr[kk * 33 + (lane & 31)] = W[(size_t)(k0 + kk) * N + ncol0 + (lane & 31)]; }
    LDS_WAIT(); asm volatile("" ::: "memory");
    const int c = lane & 7;
#pragma unroll
    for (int j = 0; j < 4; ++j) { const int n = (lane >> 3) + 8 * j; const LAS float* s = scr + (8 * c) * 33 + n;
        u32x4 o; o.x = cvt_pk_bf16(s[0 * 33], s[1 * 33]); o.y = cvt_pk_bf16(s[2 * 33], s[3 * 33]); o.z = cvt_pk_bf16(s[4 * 33], s[5 * 33]); o.w = cvt_pk_bf16(s[6 * 33], s[7 * 33]);
        *(u32x4*)(WT + (size_t)(nrow0 + n) * K + k0 + 8 * c) = o; }
    LDS_WAIT(); asm volatile("" ::: "memory");
}
__device__ __forceinline__ int srcmap1(int n) {
    if (n < 1024) return n;
    if (n < 1536) { const int t = (n - 1024) >> 8, j = (n - 1024) & 255, half = j >> 7, jj = j & 127; return 1536 + (t * 4 + (jj >> 5)) * 64 + half * 32 + (jj & 31); }
    if (n < 2560) { const int t = (n - 1536) >> 8, j = (n - 1536) & 255, half = j >> 7, jj = j & 127; return (half ? 3328 : 2304) + t * 128 + jj; }
    if (n < 3072) return 2816 + (n - 2560);
    if (n < 3328) { const int j = n - 3072, half = j >> 7, jj = j & 127; if (jj < 64) return 2048 + (jj >> 5) * 64 + half * 32 + (jj & 31); return 2176 + half * 64 + (jj - 64); }
    if (n < 3840) return 1024 + (n - 3328);
    return n;
}
__device__ __forceinline__ int srcmap4(int n) { const int t = n >> 8, j = n & 255; return (j >> 7) * DFF + t * 128 + (j & 127); }

struct Args { const float* in[20]; float* out; unsigned char* ws; int ph_lo, ph_hi; };
constexpr int NPHASE = 2 + 8 * DEPTH;

__global__ void __launch_bounds__(NWAVES * 64, 2) fwd_kernel(Args args) {
    extern __shared__ __attribute__((aligned(16))) unsigned char lds_raw[];
    LAS unsigned char* lds = (LAS unsigned char*)lds_raw;
    const int G = gridDim.x, bx = blockIdx.x;
    const int vcu = (G % 8 == 0) ? (bx % 8) * (G / 8) + bx / 8 : bx;
    const int NGW = G * NWAVES;
#define PHASE_IDS() const int tid = opaque_tid(); const int lane = tid & 63, wave = __builtin_amdgcn_readfirstlane(tid >> 6); const int gw = vcu * NWAVES + wave; (void)lane; (void)gw
    unsigned char* ws = args.ws;
    unsigned* ctl = (unsigned*)(ws + WS_CTL);
    const float* x_in = args.in[0]; const float* c_in = args.in[1]; const float* ctx_in = args.in[2]; const float* cctx_in = args.in[3];
    const float* w_ada = args.in[4]; const float* b_ada = args.in[5]; const float* norm1_g = args.in[6]; const float* norm2_g = args.in[7];
    const float* w_in = args.in[8]; const float* b_gate = args.in[9]; const float* na_rpb = args.in[10]; const float* sw_sink = args.in[11];
    const float* conv_w = args.in[12]; const float* w_br_a = args.in[13]; const float* w_br_b = args.in[14]; const float* w_br_c = args.in[15];
    const float* w_o = args.in[16]; const float* w_up = args.in[17]; const float* w_down = args.in[18]; const float* final_g = args.in[19];
    float* out = args.out;
    float* MOD = (float*)(ws + WS_MOD); float* COS = (float*)(ws + WS_COS); float* SIN = (float*)(ws + WS_SIN); float* CT = (float*)(ws + WS_CT);
    bf16_t* WB = (bf16_t*)(ws + WS_W); bf16_t* H = (bf16_t*)(ws + WS_H); float* XC = (float*)(ws + WS_XC);
    bf16_t* QA = (bf16_t*)(ws + WS_QA); bf16_t* KA = (bf16_t*)(ws + WS_KA); bf16_t* VAT = (bf16_t*)(ws + WS_VAT); bf16_t* QB = (bf16_t*)(ws + WS_QB);
    bf16_t* U = (bf16_t*)(ws + WS_U); bf16_t* CGB = (bf16_t*)(ws + WS_CGB); bf16_t* KB = (bf16_t*)(ws + WS_KB); bf16_t* VBT = (bf16_t*)(ws + WS_VBT);
    bf16_t* MERGED = (bf16_t*)(ws + WS_MERGED); bf16_t* ACT = (bf16_t*)(ws + WS_ACT);

    for (int u = threadIdx.x; u < (LDS_BYTES - LDSCTL_OFF) / 4; u += NWAVES * 64) ((LAS unsigned*)(lds + LDSCTL_OFF))[u] = 0u;
    __syncthreads();
    volatile LAS unsigned* MISC = (volatile LAS unsigned*)(lds + MISC_OFF);
    XcdBarrier bar; bar.bar = ctl + CW_BAR; bar.x = 0; bar.st = nullptr;
#if MK_SINGLE
    bar = xcd_barrier_post(ctl + CW_BAR, MISC + 8);
#endif
    const int lo = args.ph_lo, hi_ph = args.ph_hi;
#define IN(k) (lo <= (k) && (k) < hi_ph)
#define SEAM(k) do { if (IN(k) && IN((k) + 1)) xcd_barrier(bar); } while (0)

    if (IN(0)) {
        PHASE_IDS();
        LAS float* scr = (LAS float*)(lds + RING_OFF + wave * 16384);
        constexpr int I_W1 = (NIN / 32) * (D / 64), I_BR = (D / 32) * (512 / 64), I_WO = (D / 32) * (D / 64), I_W4 = (2 * DFF / 32) * (D / 64), I_W5 = (D / 32) * (DFF / 64);
        constexpr int I_LAYER = I_W1 + 3 * I_BR + I_WO + I_W4 + I_W5;
        for (int it = gw; it < DEPTH * I_LAYER; it += NGW) {
            const int l = it / I_LAYER; int r = it - l * I_LAYER;
            bf16_t* wl = WB + (size_t)l * W_LAYER_ELEMS;
            if (r < I_W1) { const int kb = r / (NIN / 32), nb = r % (NIN / 32); transpose_item(w_in + (size_t)l * D * NIN, D, NIN, wl + WO_W1, srcmap1(nb * 32), nb * 32, kb * 64, scr, lane); continue; } r -= I_W1;
            if (r < 3 * I_BR) { const int br = r / I_BR, rr = r % I_BR, kb = rr / (D / 32), nb = rr % (D / 32); const float* src = (br == 0 ? w_br_a : (br == 1 ? w_br_b : w_br_c)) + (size_t)l * 512 * D;
                transpose_item(src, 512, D, wl + WO_WBR + (size_t)br * D * 512, nb * 32, nb * 32, kb * 64, scr, lane); continue; } r -= 3 * I_BR;
            if (r < I_WO) { const int kb = r / (D / 32), nb = r % (D / 32); transpose_item(w_o + (size_t)l * D * D, D, D, wl + WO_WO, nb * 32, nb * 32, kb * 64, scr, lane); continue; } r -= I_WO;
            if (r < I_W4) { const int kb = r / (2 * DFF / 32), nb = r % (2 * DFF / 32); transpose_item(w_up + (size_t)l * D * 2 * DFF, D, 2 * DFF, wl + WO_W4, srcmap4(nb * 32), nb * 32, kb * 64, scr, lane); continue; } r -= I_W4;
            { const int kb = r / (D / 32), nb = r % (D / 32); transpose_item(w_down + (size_t)l * DFF * D, DFF, D, wl + WO_W5, nb * 32, nb * 32, kb * 64, scr, lane); }
        }
        __syncthreads();
        {
            LAS float* sl = (LAS float*)(lds + RING_OFF);
            LAS float* red = (LAS float*)(lds + RING_OFF + 32768);
            for (int i = tid; i < 5 * D; i += NWAVES * 64) { const int bi = i >> 10, k = i & 1023; const float v = (bi < 4) ? c_in[bi * D + k] : cctx_in[k]; sl[i] = v / (1.0f + __expf(-v)); }
            __syncthreads();
            for (int it = bx; it < DEPTH * 96; it += G) {
                const int l = it / 96, n = (it % 96) * 64 + lane;
                const float* wp = w_ada + ((size_t)l * D + wave * 128) * 6144 + n;
                float a0 = 0.f, a1 = 0.f, a2 = 0.f, a3 = 0.f, a4 = 0.f;
#pragma unroll 8
                for (int k = 0; k < 128; ++k) { const float w = wp[(size_t)k * 6144]; const int kk = wave * 128 + k;
                    a0 += sl[kk] * w; a1 += sl[1024 + kk] * w; a2 += sl[2048 + kk] * w; a3 += sl[3072 + kk] * w; a4 += sl[4096 + kk] * w; }
                red[(wave * 5 + 0) * 64 + lane] = a0; red[(wave * 5 + 1) * 64 + lane] = a1; red[(wave * 5 + 2) * 64 + lane] = a2; red[(wave * 5 + 3) * 64 + lane] = a3; red[(wave * 5 + 4) * 64 + lane] = a4;
                __syncthreads();
                if (tid < 320) { const int bi = tid >> 6, ln = tid & 63; float s = b_ada[l * 6144 + (it % 96) * 64 + ln];
#pragma unroll
                    for (int w = 0; w < 8; ++w) s += red[(w * 5 + bi) * 64 + ln];
                    MOD[((size_t)l * 5 + bi) * 6144 + (it % 96) * 64 + ln] = s; }
                __syncthreads();
            }
        }
        for (int i = gw * 64 + lane; i < SEQ * 32; i += NGW * 64) { const int t = i >> 5, p = i & 31; const float pos = (p < 16) ? (float)(t >> 6) : (float)(t & 63);
            const float inv = powf(10000.0f, -(float)(p & 15) / 16.0f); const float ang = pos * inv; COS[i] = cosf(ang); SIN[i] = sinf(ang); }
        for (int i = gw * 64 + lane; i < DEPTH * 8 * 15 * 4 * 1024; i += NGW * 64) {
            const int r = ((i >> 8) & 3) * 4 + (i & 3), ln = (i >> 2) & 63, kb = (i >> 10) & 1, qb = (i >> 11) & 1; const int rest = i >> 12; const int drow = rest % 15, lh = rest / 15;
            const int q32 = ln & 31, hh = ln >> 5; const int koff = 16 * (r >> 3) + 8 * hh + (r & 7); const int kc = kb * 32 + koff, c = qb * 32 + q32;
            const int c0 = min(max(c - 8, 0), 48); const bool ok = (kc >= c0) && (kc < c0 + 16);
            CT[i] = ok ? na_rpb[((size_t)lh * 15 + drow) * 31 + (kc - c + 15)] * LOG2E : NEGBIG;
        }
    }
    SEAM(0);

    for (int l = 0; l < DEPTH; ++l) {
        const int P = 1 + 8 * l;
        const bool lastl = (l == DEPTH - 1);
        const float* modl = MOD + (size_t)l * 5 * 6144;
        const bf16_t* wl = WB + (size_t)l * W_LAYER_ELEMS;
        const float* xlat = (l == 0) ? x_in : out;
        const float* xctx = (l == 0) ? ctx_in : XC;
        if (IN(P + 0)) {
            PHASE_IDS();
            for (int row = gw; row < MT; row += NGW) {
                const bool latent = row < MLAT; const float* xr = latent ? xlat + (size_t)row * D : xctx + (size_t)(row - MLAT) * D;
                const float* mv = modl + (latent ? (row >> 13) : 4) * 6144; const float* gp = norm1_g + l * D;
                f32x4 v[4]; float ss = 0.f;
#pragma unroll
                for (int j = 0; j < 4; ++j) { v[j] = *(const f32x4*)(xr + 256 * j + 4 * lane); ss += (v[j][0] * v[j][0] + v[j][1] * v[j][1]) + (v[j][2] * v[j][2] + v[j][3] * v[j][3]); }
                const float rinv = 1.0f / sqrtf(wave_sum(ss) * (1.0f / D) + NORM_EPS);
#pragma unroll
                for (int j = 0; j < 4; ++j) { const int c = 256 * j + 4 * lane; const f32x4 g = *(const f32x4*)(gp + c), sh = *(const f32x4*)(mv + c), sc = *(const f32x4*)(mv + 1024 + c);
                    const f32x4 y = (v[j] * rinv * g) * (1.0f + sc) + sh; u32x2 w; w.x = cvt_pk_bf16(y[0], y[1]); w.y = cvt_pk_bf16(y[2], y[3]); *(u32x2*)(H + (size_t)row * D + c) = w; }
            }
        }
        SEAM(P + 0);
        if (IN(P + 1)) {
            pg8::G1Sched S{(const char*)H, (const char*)(wl + WO_W1), NPAN, G, bx};
            pg8::EpiG1 E{QA, KA, VAT, QB, U, CGB, KB, VBT, COS, SIN};
            pg8::gemm_phase<pg8::EpiG1, pg8::G1Sched>(lds + RING_OFF, S, E);
            if (PROBE_DUP & (1 << 1)) pg8::gemm_phase<pg8::EpiG1, pg8::G1Sched>(lds + RING_OFF, S, E);
        }
        SEAM(P + 1);
        if (IN(P + 2)) {
            PHASE_IDS();
            AttnPtrs AP{QA, KA, VAT, QB, KB, VBT, CT, sw_sink};
            if (PROBE_DUP & (1 << 2)) {
                bf16_t* dump = (bf16_t*)(ws + WS_SCR);
                for (int t = gw; t < NBATCH * 8 * 256; t += NGW) { const int bh = t >> 8, r = (t >> 1) & 127, half = t & 1; na_task(AP, l, bh >> 3, bh & 7, r, half, lane, dump); }
                for (int t = gw; t < NBATCH * 8 * 256; t += NGW) { const int bh = t >> 8, qblk = t & 255; swa_task(AP, l, bh >> 3, bh & 7, qblk, lane, dump); }
                if (!lastl) for (int t = gw; t < 2 * NBATCH * 8 * 8; t += NGW) { const int typ = t >> 8, bh = (t >> 3) & 31, qblk = t & 7; ctx_task(AP, l, typ, bh >> 3, bh & 7, qblk, lane, dump); }
            }
            for (int t = gw; t < NBATCH * 8 * 256; t += NGW) { const int bh = t >> 8, r = (t >> 1) & 127, half = t & 1; na_task(AP, l, bh >> 3, bh & 7, r, half, lane, nullptr); }
            for (int t = gw; t < NBATCH * 8 * 256; t += NGW) { const int bh = t >> 8, qblk = t & 255; swa_task(AP, l, bh >> 3, bh & 7, qblk, lane, nullptr); }
            if (!lastl) for (int t = gw; t < 2 * NBATCH * 8 * 8; t += NGW) { const int typ = t >> 8, bh = (t >> 3) & 31, qblk = t & 7; ctx_task(AP, l, typ, bh >> 3, bh & 7, qblk, lane, nullptr); }
            const int nrows = lastl ? MLAT : MT;
            const float* cw = conv_w + (size_t)l * 3 * 512;
            for (int it = gw * 64 + lane; it < nrows * 64; it += NGW * 64) {
                const int row = it >> 6, ch = (it & 63) * 8;
                const bool latent = row < MLAT; const int tl = latent ? (row & (SEQ - 1)) : ((row - MLAT) & (CTXL - 1)); const int tmax = latent ? SEQ - 1 : CTXL - 1;
                const u32x4 zero = {0u, 0u, 0u, 0u};
                const u32x4 um = (tl > 0) ? *(const u32x4*)(U + (size_t)(row - 1) * 512 + ch) : zero;
                const u32x4 uc = *(const u32x4*)(U + (size_t)row * 512 + ch);
                const u32x4 up = (tl < tmax) ? *(const u32x4*)(U + (size_t)(row + 1) * 512 + ch) : zero;
                const u32x4 gb = *(const u32x4*)(CGB + (size_t)row * 512 + ch);
                f32x4 m0, m1, c0, c1, p0, p1, g0, g1; unpack8(um, m0, m1); unpack8(uc, c0, c1); unpack8(up, p0, p1); unpack8(gb, g0, g1);
                const f32x4 w00 = *(const f32x4*)(cw + ch), w01 = *(const f32x4*)(cw + ch + 4), w10 = *(const f32x4*)(cw + 512 + ch), w11 = *(const f32x4*)(cw + 512 + ch + 4), w20 = *(const f32x4*)(cw + 1024 + ch), w21 = *(const f32x4*)(cw + 1024 + ch + 4);
                const f32x4 y0 = g0 * (w00 * m0 + w10 * c0 + w20 * p0), y1 = g1 * (w01 * m1 + w11 * c1 + w21 * p1);
                *(u32x4*)(CGB + (size_t)row * 512 + ch) = pack8(y0, y1);
            }
        }
        SEAM(P + 2);
        const int nMl = lastl ? NPAN_LAT : NPAN;
        if (IN(P + 3)) {
            pg8::G2Sched S{(const char*)H, (const char*)(wl + WO_W1), (const char*)QA, (const char*)(wl + WO_WBR), nMl, G, bx};
            u32x4* scrg = (u32x4*)(ws + WS_SCR + (size_t)bx * 262144);
            pg8::EpiG2 E{scrg, scrg + 8192, MERGED, b_gate + (size_t)l * 3072};
            pg8::gemm_phase<pg8::EpiG2, pg8::G2Sched>(lds + RING_OFF, S, E);
            if (PROBE_DUP & (1 << 3)) pg8::gemm_phase<pg8::EpiG2, pg8::G2Sched>(lds + RING_OFF, S, E);
        }
        SEAM(P + 3);
        if (IN(P + 4)) {
            pg8::SimpleSched S{(const char*)MERGED, (const char*)(wl + WO_WO), 2048, 2048, 16, nMl, 4, G, bx};
            pg8::EpiRes E{xlat, xctx, out, XC, modl, 2048};
            pg8::gemm_phase<pg8::EpiRes, pg8::SimpleSched>(lds + RING_OFF, S, E);
        }
        SEAM(P + 4);
        if (IN(P + 5)) {
            PHASE_IDS();
            const int nrows = lastl ? MLAT : MT;
            for (int row = gw; row < nrows; row += NGW) {
                const bool latent = row < MLAT; const float* xr = latent ? out + (size_t)row * D : XC + (size_t)(row - MLAT) * D;
                const float* mv = modl + (latent ? (row >> 13) : 4) * 6144 + 3072; const float* gp = norm2_g + l * D;
                f32x4 v[4]; float ss = 0.f;
#pragma unroll
                for (int j = 0; j < 4; ++j) { v[j] = *(const f32x4*)(xr + 256 * j + 4 * lane); ss += (v[j][0] * v[j][0] + v[j][1] * v[j][1]) + (v[j][2] * v[j][2] + v[j][3] * v[j][3]); }
                const float rinv = 1.0f / sqrtf(wave_sum(ss) * (1.0f / D) + NORM_EPS);
#pragma unroll
                for (int j = 0; j < 4; ++j) { const int c = 256 * j + 4 * lane; const f32x4 g = *(const f32x4*)(gp + c), sh = *(const f32x4*)(mv + c), sc = *(const f32x4*)(mv + 1024 + c);
                    const f32x4 y = (v[j] * rinv * g) * (1.0f + sc) + sh; u32x2 w; w.x = cvt_pk_bf16(y[0], y[1]); w.y = cvt_pk_bf16(y[2], y[3]); *(u32x2*)(H + (size_t)row * D + c) = w; }
            }
        }
        SEAM(P + 5);
        if (IN(P + 6)) {
            pg8::SimpleSched S{(const char*)H, (const char*)(wl + WO_W4), 2048, 2048, 16, nMl, 22, G, bx};
            pg8::EpiSwiglu E{ACT};
            pg8::gemm_phase<pg8::EpiSwiglu, pg8::SimpleSched>(lds + RING_OFF, S, E);
            if (PROBE_DUP & (1 << 6)) pg8::gemm_phase<pg8::EpiSwiglu, pg8::SimpleSched>(lds + RING_OFF, S, E);
        }
        SEAM(P + 6);
        if (IN(P + 7)) {
            pg8::SimpleSched S{(const char*)ACT, (const char*)(wl + WO_W5), 2 * DFF, 2 * DFF, DFF / 64, nMl, 4, G, bx};
            pg8::EpiRes E{out, XC, out, XC, modl, 5120};
            pg8::gemm_phase<pg8::EpiRes, pg8::SimpleSched>(lds + RING_OFF, S, E);
        }
        SEAM(P + 7);
    }
    if (IN(NPHASE - 1)) {
        PHASE_IDS();
        for (int row = gw; row < MLAT; row += NGW) {
            float* xr = out + (size_t)row * D;
            f32x4 v[4]; float ss = 0.f;
#pragma unroll
            for (int j = 0; j < 4; ++j) { v[j] = *(const f32x4*)(xr + 256 * j + 4 * lane); ss += (v[j][0] * v[j][0] + v[j][1] * v[j][1]) + (v[j][2] * v[j][2] + v[j][3] * v[j][3]); }
            const float rinv = 1.0f / sqrtf(wave_sum(ss) * (1.0f / D) + NORM_EPS);
#pragma unroll
            for (int j = 0; j < 4; ++j) { const int c = 256 * j + 4 * lane; const f32x4 g = *(const f32x4*)(final_g + c); *(f32x4*)(xr + c) = v[j] * rinv * g; }
        }
    }
#undef IN
#undef SEAM
}

extern "C" void kernel_launch(void* const* d_in, const int* in_sizes, int n_in, void* d_out, int out_size, void* d_ws, size_t ws_size, hipStream_t stream) {
    static int grid = 0;
    if (grid == 0) {
        if (n_in != 20 || in_sizes[0] != MLAT * D || out_size != MLAT * D || ws_size < WS_END) {
            fprintf(stderr, "kernel_launch: unexpected shapes: n_in %d in0 %d out %d ws %zu (need %zu); nothing launched\n", n_in, n_in > 0 ? in_sizes[0] : -1, out_size, ws_size, (size_t)WS_END); grid = -1; return; }
        int dev = 0, cus = 0, per_cu = 0;
        if (hipGetDevice(&dev) != hipSuccess || hipDeviceGetAttribute(&cus, hipDeviceAttributeMultiprocessorCount, dev) != hipSuccess) { fprintf(stderr, "kernel_launch: device query failed\n"); grid = -1; return; }
        if (hipFuncSetAttribute((const void*)fwd_kernel, hipFuncAttributeMaxDynamicSharedMemorySize, LDS_BYTES) != hipSuccess) { fprintf(stderr, "kernel_launch: hipFuncSetAttribute failed\n"); grid = -1; return; }
        if (hipOccupancyMaxActiveBlocksPerMultiprocessor(&per_cu, (const void*)fwd_kernel, NWAVES * 64, LDS_BYTES) != hipSuccess || per_cu < 1)
            fprintf(stderr, "kernel_launch: note: occupancy query reports %d workgroups per CU\n", per_cu);
        (void)hipGetLastError();
        grid = cus > 256 ? 256 : cus;
    }
    if (grid < 0) return;
    if (hipMemsetAsync((char*)d_ws + WS_CTL, 0, CTL_ZERO_BYTES, stream) != hipSuccess) { fprintf(stderr, "kernel_launch: memset failed\n"); return; }
    Args a{};
    for (int i = 0; i < 20; ++i) a.in[i] = (const float*)d_in[i];
    a.out = (float*)d_out; a.ws = (unsigned char*)d_ws;
#if MK_SINGLE
    a.ph_lo = 0; a.ph_hi = NPHASE;
    hipLaunchKernelGGL(fwd_kernel, dim3(grid), dim3(NWAVES * 64), LDS_BYTES, stream, a);
#else
    for (int p = 0; p < NPHASE; ++p) { a.ph_lo = p; a.ph_hi = p + 1; hipLaunchKernelGGL(fwd_kernel, dim3(grid), dim3(NWAVES * 64), LDS_BYTES, stream, a); }
#endif
    const hipError_t le = hipPeekAtLastError();
    if (le != hipSuccess) fprintf(stderr, "kernel_launch: launch failed: %s\n", hipGetErrorName(le));
}
```

```cpp
#include <hip/hip_runtime.h>
#include <cstdio>
#include <cstdint>

#ifndef MK_SINGLE
#define MK_SINGLE 1
#endif

#ifndef CTX_GATES
#define CTX_GATES 1
#endif
#ifndef CTX_SPLITK
#define CTX_SPLITK 1
#endif
#ifndef PROBE_DUP
#define PROBE_DUP 0
#endif
#define GAS __attribute__((address_space(1)))
#define LAS __attribute__((address_space(3)))
typedef unsigned short bf16_t;
typedef short bf16x8 __attribute__((ext_vector_type(8)));
typedef float f32x4 __attribute__((ext_vector_type(4)));
typedef float f32x2 __attribute__((ext_vector_type(2)));
typedef float f32x16 __attribute__((ext_vector_type(16)));
typedef unsigned u32x4 __attribute__((ext_vector_type(4)));
typedef unsigned u32x2 __attribute__((ext_vector_type(2)));

constexpr int D = 1024, NBATCH = 4, SEQ = 8192, DEPTH = 4, CTXL = 256;
constexpr int MLAT = NBATCH * SEQ;
constexpr int MCTX = NBATCH * CTXL;
constexpr int MT = MLAT + MCTX;
constexpr int NPAN = MT / 256;
constexpr int NPAN_LAT = MLAT / 256;
constexpr int NIN = 6912, DFF = 2816;
constexpr float NORM_EPS = 1e-6f;
constexpr float LOG2E = 1.4426950408889634f;
constexpr float C2 = 0.125f * LOG2E;
constexpr float NEGBIG = -30000.0f;

constexpr size_t MiB = 1u << 20;
constexpr size_t WS_CTL = 0, CTL_ZERO_BYTES = 1 * MiB;
constexpr size_t WS_MOD = 1 * MiB;
constexpr size_t WS_COS = 2 * MiB, WS_SIN = 3 * MiB;
constexpr size_t WS_CT = 4 * MiB;
constexpr size_t WS_W = 12 * MiB;
constexpr size_t W_LAYER_ELEMS = 18350080;
constexpr size_t WO_W1 = 0, WO_WBR = 7077888, WO_WO = 8650752, WO_W4 = 9699328, WO_W5 = 15466496;
constexpr size_t WS_H = 152 * MiB;
constexpr size_t WS_XC = 218 * MiB;
constexpr size_t WS_Z = 222 * MiB;
constexpr size_t Z33 = 33 * MiB;
constexpr size_t WS_QA = WS_Z, WS_QB = WS_Z + Z33, WS_CGB = WS_Z + 2 * Z33, WS_KA = WS_Z + 3 * Z33, WS_VAT = WS_Z + 4 * Z33, WS_U = WS_Z + 5 * Z33;
constexpr size_t WS_KB = WS_Z + 6 * Z33, WS_VBT = WS_KB + (size_t)MT * 128 * 2;
constexpr size_t WS_MERGED = WS_KA;
constexpr size_t WS_ACT = WS_Z;
constexpr size_t WS_SCR = 437 * MiB;
constexpr size_t WS_GATEC = 501 * MiB;
constexpr size_t WS_END = 507 * MiB;
static_assert(WS_VBT + (size_t)MT * 128 * 2 <= WS_SCR, "ws map");
static_assert(WS_ACT + (size_t)MT * DFF * 2 <= WS_KB, "act overlay");
static_assert(WS_W + 4 * W_LAYER_ELEMS * 2 <= WS_H, "weights");

constexpr int CW_BAR = 4096;

constexpr int RING_OFF = 0, RING_BYTES = 131072;
constexpr int LDSCTL_OFF = RING_BYTES, MISC_OFF = LDSCTL_OFF + 320;
constexpr int LDS_BYTES = 147456;
constexpr int NWAVES = 8;

typedef __bf16 bf16x2_t __attribute__((ext_vector_type(2)));
__device__ __forceinline__ unsigned cvt_pk_bf16(float lo, float hi) { const f32x2 v = {lo, hi}; const bf16x2_t b = __builtin_convertvector(v, bf16x2_t); return __builtin_bit_cast(unsigned, b); }
__device__ __forceinline__ float bf_lo(unsigned w) { return __uint_as_float(w << 16); }
__device__ __forceinline__ float bf_hi(unsigned w) { return __uint_as_float(w & 0xffff0000u); }
__device__ __forceinline__ unsigned short f2bf(float f) { return (unsigned short)(cvt_pk_bf16(f, 0.f) & 0xffffu); }
__device__ __forceinline__ float fast_sigmoid(float x) { return __builtin_amdgcn_rcpf(1.0f + __builtin_amdgcn_exp2f(-x * LOG2E)); }
__device__ __forceinline__ u32x4 pack8(f32x4 a, f32x4 b) { u32x4 w; w.x = cvt_pk_bf16(a[0], a[1]); w.y = cvt_pk_bf16(a[2], a[3]); w.z = cvt_pk_bf16(b[0], b[1]); w.w = cvt_pk_bf16(b[2], b[3]); return w; }
__device__ __forceinline__ void unpack8(u32x4 w, f32x4& a, f32x4& b) { a[0] = bf_lo(w.x); a[1] = bf_hi(w.x); a[2] = bf_lo(w.y); a[3] = bf_hi(w.y); b[0] = bf_lo(w.z); b[1] = bf_hi(w.z); b[2] = bf_lo(w.w); b[3] = bf_hi(w.w); }
__device__ __forceinline__ float wave_sum(float v) {
#pragma unroll
    for (int o = 1; o < 64; o <<= 1) v += __shfl_xor(v, o);
    return v;
}
#define LDS_WAIT() asm volatile("s_waitcnt lgkmcnt(0)" ::: "memory")
__device__ __forceinline__ int opaque_tid() { int t = threadIdx.x; asm volatile("" : "+v"(t)); return t; }
typedef GAS bf16_t* gbf_p; typedef GAS float* gf32_p; typedef const GAS float* gcf32_p; typedef GAS u32x4* gu4_p;
__device__ __forceinline__ void st16(const void* base, unsigned off, u32x4 v) { *(GAS u32x4*)((GAS char*)base + off) = v; }
__device__ __forceinline__ void st16f(const void* base, unsigned off, f32x4 v) { *(GAS f32x4*)((GAS char*)base + off) = v; }
__device__ __forceinline__ void st2(const void* base, unsigned off, unsigned short v) { *(GAS unsigned short*)((GAS char*)base + off) = v; }
__device__ __forceinline__ u32x4 ld16(const void* base, unsigned off) { return *(const GAS u32x4*)((const GAS char*)base + off); }
__device__ __forceinline__ f32x4 ld16f(const void* base, unsigned off) { return *(const GAS f32x4*)((const GAS char*)base + off); }
#define OPAQUE_S(p) asm volatile("" : "+s"(p))

#define XB_TMO      128
#define XB_XCNT(j)  (256  + 64 * (j))
#define XB_XSUB(j)  (1280 + 64 * (j))
#define XB_XGEN(j)  (2304 + 64 * (j))
#define XB_TOP      3328
#define XB_TOPGEN   3392
#define XCD_BAR_WORDS 3456
#define XB_SPIN_CAP (1u << 18)
__device__ __forceinline__ unsigned xb_ld(unsigned* p)              { return __hip_atomic_load(p, __ATOMIC_RELAXED, __HIP_MEMORY_SCOPE_AGENT); }
__device__ __forceinline__ unsigned xb_add(unsigned* p, unsigned v) { return __hip_atomic_fetch_add(p, v, __ATOMIC_RELAXED, __HIP_MEMORY_SCOPE_AGENT); }
__device__ __forceinline__ unsigned xb_xcc_id() { return (unsigned)__builtin_amdgcn_s_getreg((3 << 11) | 20) & 0xFu; }
#define XB_SPIN(cond, bar) do { unsigned _sp = 0; while (cond) { __builtin_amdgcn_s_sleep(1); \
    if ((++_sp & 255u) == 0u) { if (xb_ld(&(bar)[XB_TMO])) break; if (_sp > XB_SPIN_CAP) { atomicAdd(&(bar)[XB_TMO], 1u); break; } } } } while (0)
struct XcdBarrier { unsigned* bar; unsigned x; volatile LAS unsigned* st; };
__device__ __forceinline__ XcdBarrier xcd_barrier_post(unsigned* bar, volatile LAS unsigned* st) {
    XcdBarrier b; b.bar = bar; b.x = xb_xcc_id(); b.st = st;
    if (threadIdx.x == 0) (void)xb_add(&bar[XB_XCNT(b.x)], 1u);
    return b;
}
__device__ __forceinline__ void xcd_barrier_complete(unsigned* bar, unsigned x, unsigned& nloc, unsigned& nx) {
    const unsigned G = gridDim.x * gridDim.y * gridDim.z;
    unsigned sum, cnt, mine, sp = 0u;
    for (;;) {
        sum = 0u; cnt = 0u; mine = 0u;
#pragma unroll
        for (unsigned j = 0; j < 16; ++j) { const unsigned c = xb_ld(&bar[XB_XCNT(j)]); sum += c; cnt += (c > 0u) ? 1u : 0u; mine = (j == x) ? c : mine; }
        if (sum == G) break;
        __builtin_amdgcn_s_sleep(1);
        if ((++sp & 255u) == 0u) { if (xb_ld(&bar[XB_TMO])) break; if (sp > XB_SPIN_CAP) { atomicAdd(&bar[XB_TMO], 1u); break; } }
    }
    nloc = mine > 0u ? mine : 1u; nx = cnt > 0u ? cnt : 1u;
}
__device__ __forceinline__ void xcd_barrier(const XcdBarrier& b) {
    asm volatile("s_waitcnt vmcnt(0)" ::: "memory");
    __syncthreads();
    if (threadIdx.x == 0) {
        unsigned* bar = b.bar;
        __builtin_amdgcn_s_waitcnt(0);
        unsigned nloc = b.st[0], nx = b.st[1];
        if (nloc == 0u) { xcd_barrier_complete(bar, b.x, nloc, nx); b.st[0] = nloc; b.st[1] = nx; }
        const unsigned old = xb_add(&bar[XB_XSUB(b.x)], 1u);
        const unsigned gen = old / nloc;
        if (old + 1u == (gen + 1u) * nloc) {
            __builtin_amdgcn_fence(__ATOMIC_RELEASE, "agent");
            asm volatile("s_waitcnt vmcnt(0)" ::: "memory");
            const unsigned og = xb_add(&bar[XB_TOP], 1u);
            const unsigned tg = og / nx;
            if (og + 1u == (tg + 1u) * nx) xb_add(&bar[XB_TOPGEN], 1u);
            else XB_SPIN(xb_ld(&bar[XB_TOPGEN]) == tg, bar);
            __builtin_amdgcn_fence(__ATOMIC_ACQUIRE, "agent");
            xb_add(&bar[XB_XGEN(b.x)], 1u);
            asm volatile("s_waitcnt vmcnt(0)" ::: "memory");
        } else {
            XB_SPIN(xb_ld(&bar[XB_XGEN(b.x)]) == gen, bar);
            __builtin_amdgcn_fence(__ATOMIC_ACQUIRE, "agent");
            asm volatile("s_waitcnt vmcnt(0)" ::: "memory");
        }
    }
    __syncthreads();
}

namespace pg8 {
constexpr int BM = 256, BK = 64, HALF = 128, HTB = HALF * BK * 2, STAGE_BYTES = 8 * HTB, NXCD = 8, WGM = 8;
__host__ __device__ __forceinline__ int lds_byte(int r, int c) { const int st = (r >> 4) * 2 + (c >> 5), rr = r & 15, cc = c & 31, ob = rr * 64 + cc * 2; return st * 1024 + (ob ^ (((ob >> 9) & 1) << 5)); }
__host__ __device__ __forceinline__ void stage_rc(int b, int& R, int& C) { const int st = b / 1024, sb = b % 1024, swz = sb ^ (((sb >> 9) & 1) << 5); R = (st >> 1) * 16 + swz / 64; C = (st & 1) * 32 + (swz % 64) / 2; }
__host__ __device__ __forceinline__ int perm32(int rho) { const int n = rho >> 4, i = rho & 15; return 8 * (i >> 2) + 4 * n + (i & 3); }

struct GUnit { const char* A; const char* B; unsigned lda2, ldb2; int nt; int pm, pn, mode; };

__device__ __forceinline__ bool tile_order(long L, int nM, int nN, int& pm, int& pn) {
    const int nwg = nM * nN; if (L >= nwg) return false;
    int wgid = (int)L; { const int q = nwg / NXCD, r = nwg % NXCD, xcd = wgid % NXCD, off = wgid / NXCD; wgid = (xcd < r ? xcd * (q + 1) : r * (q + 1) + (xcd - r) * q) + off; }
    const int nig = WGM * nN, gid = wgid / nig, fm = gid * WGM, gsz = (nM - fm) < WGM ? (nM - fm) : WGM;
    pm = fm + ((wgid % nig) % gsz); pn = (wgid % nig) / gsz; return true;
}

template <class Epi, class Sched>
__device__ __forceinline__ void gemm_phase(LAS unsigned char* lds, const Sched& S, const Epi& E) {
    const int tid = opaque_tid(), wid = __builtin_amdgcn_readfirstlane(tid >> 6), lane = tid & 63, wr = wid >> 2, wc = wid & 3, fr = lane & 15, fq = lane >> 4;
    const size_t kstep = (size_t)(BK * 2);
    const unsigned ldsw = (unsigned)wid * 1024u;
    const int aoff = lds_byte(wr * 64 + fr, fq * 8), boff = lds_byte(wc * 32 + fr, fq * 8);
#define PG8_SA(b, h) (((b) * 2 + (h)) * HTB)
#define PG8_SB(b, h) ((4 + (b) * 2 + (h)) * HTB)
#define PG8_STAGE(bufoff, gbase, voff) do { _Pragma("unroll") for (int _i = 0; _i < 2; ++_i) \
        __builtin_amdgcn_global_load_lds((const unsigned*)((const char*)(gbase) + (voff)[_i]), (LAS unsigned*)(lds + (bufoff) + ldsw + _i * 8192), 16, 0, 0); } while (0)
#define PG8_LDA(dst, b, h) do { _Pragma("unroll") for (int m = 0; m < 4; ++m) _Pragma("unroll") for (int k = 0; k < 2; ++k) dst[m][k] = *(const LAS bf16x8*)(lds + PG8_SA(b, h) + aoff + m * 2048 + k * 1024); } while (0)
#define PG8_LDB(dst, b, h) do { _Pragma("unroll") for (int n = 0; n < 2; ++n) _Pragma("unroll") for (int k = 0; k < 2; ++k) dst[n][k] = *(const LAS bf16x8*)(lds + PG8_SB(b, h) + boff + n * 2048 + k * 1024); } while (0)
#define PG8_MMA(ai, bj, At, Bt) do { __builtin_amdgcn_s_setprio(1); _Pragma("unroll") for (int m = 0; m < 4; ++m) _Pragma("unroll") for (int n = 0; n < 2; ++n) _Pragma("unroll") for (int k = 0; k < 2; ++k) \
        acc[ai][bj][m][n] = __builtin_amdgcn_mfma_f32_16x16x32_bf16(Bt[n][k], At[m][k], acc[ai][bj][m][n], 0, 0, 0); __builtin_amdgcn_s_setprio(0); } while (0)
#define PG8_WAIT_V(n) asm volatile("s_waitcnt vmcnt(" #n ")" ::: "memory")
#define PG8_WAIT_L(n) asm volatile("s_waitcnt lgkmcnt(" #n ")" ::: "memory")
#define PG8_BAR __builtin_amdgcn_s_barrier()
#define PG8_SCHED __builtin_amdgcn_sched_barrier(0)
#define PG8_VOFF(u, vA, vB) do { int t_ = tid; asm volatile("" : "+v"(t_)); _Pragma("unroll") for (int _i = 0; _i < 2; ++_i) { int R_, C_; stage_rc(t_ * 16 + _i * 8192, R_, C_); \
        const unsigned Rb_ = (unsigned)(Epi::PERM ? ((R_ & ~31) + perm32(R_ & 31)) : R_); vA[_i] = (unsigned)R_ * (u).lda2 + (unsigned)C_ * 2u; vB[_i] = Rb_ * (u).ldb2 + (unsigned)C_ * 2u; } } while (0)
    GUnit cur, nxt; int ui = 0;
    if (!S.next(0, cur)) return;
    f32x4 acc[2][2][4][2];
#pragma unroll
    for (int a = 0; a < 2; ++a)
#pragma unroll
        for (int b = 0; b < 2; ++b)
#pragma unroll
            for (int m = 0; m < 4; ++m)
#pragma unroll
                for (int n = 0; n < 2; ++n) acc[a][b][m][n] = (f32x4){0.f, 0.f, 0.f, 0.f};
    bf16x8 At[4][2], B0[2][2], B1[2][2];
    unsigned vA[2], vB[2], nvA[2], nvB[2];
    PG8_VOFF(cur, vA, vB);
    const char* cA = cur.A; const char* cB = cur.B;
    size_t hA = (size_t)HALF * cur.lda2, hB = (size_t)HALF * cur.ldb2;
    PG8_STAGE(PG8_SB(0, 0), cB, vB); PG8_STAGE(PG8_SB(0, 1), cB + hB, vB); PG8_STAGE(PG8_SA(0, 0), cA, vA); PG8_STAGE(PG8_SA(0, 1), cA + hA, vA);
    if (wr == 1) PG8_BAR;
    PG8_WAIT_V(2); PG8_BAR;
    PG8_STAGE(PG8_SB(1, 0), cB + kstep, vB); PG8_STAGE(PG8_SA(1, 0), cA + kstep, vA); PG8_STAGE(PG8_SB(1, 1), cB + hB + kstep, vB);
    PG8_WAIT_V(6); PG8_BAR;
    for (;;) {
        const bool has_next = S.next(ui + 1, nxt);
        const char* nA = cA; const char* nB = cB; size_t nhA = hA, nhB = hB;
        nvA[0] = vA[0]; nvA[1] = vA[1]; nvB[0] = vB[0]; nvB[1] = vB[1];
        if (has_next) { nA = nxt.A; nB = nxt.B; nhA = (size_t)HALF * nxt.lda2; nhB = (size_t)HALF * nxt.ldb2; PG8_VOFF(nxt, nvA, nvB); }
        const int nt = cur.nt;
        for (int t = 0; t < nt; t += 2) {
            const bool last = (t == nt - 2);
            const char* a1 = cA + (size_t)(t + 1) * kstep;
            const char* a2 = last ? nA : cA + (size_t)(t + 2) * kstep; const char* b2 = last ? nB : cB + (size_t)(t + 2) * kstep;
            const char* a3 = a2 + kstep; const char* b3 = b2 + kstep;
            unsigned wA[2], wB[2]; wA[0] = last ? nvA[0] : vA[0]; wA[1] = last ? nvA[1] : vA[1]; wB[0] = last ? nvB[0] : vB[0]; wB[1] = last ? nvB[1] : vB[1];
            const size_t hA2 = last ? nhA : hA, hB2 = last ? nhB : hB;
            PG8_LDB(B0, 0, 0); PG8_LDB(B1, 0, 1); PG8_SCHED; PG8_LDA(At, 0, 0); PG8_STAGE(PG8_SA(1, 1), a1 + hA, vA);
            PG8_WAIT_V(8); PG8_WAIT_L(0); PG8_BAR; PG8_MMA(0, 0, At, B0); PG8_MMA(0, 1, At, B1); PG8_BAR; PG8_SCHED;
            PG8_LDA(At, 0, 1); PG8_STAGE(PG8_SB(0, 0), b2, wB); PG8_STAGE(PG8_SB(0, 1), b2 + hB2, wB); PG8_STAGE(PG8_SA(0, 0), a2, wA);
            PG8_WAIT_V(8); PG8_WAIT_L(0); PG8_BAR; PG8_MMA(1, 0, At, B0); PG8_MMA(1, 1, At, B1); PG8_BAR; PG8_SCHED;
            PG8_LDB(B0, 1, 0); PG8_LDB(B1, 1, 1); PG8_SCHED; PG8_LDA(At, 1, 0); PG8_STAGE(PG8_SA(0, 1), a2 + hA2, wA);
            PG8_WAIT_V(8); PG8_WAIT_L(0); PG8_BAR; PG8_MMA(0, 0, At, B0); PG8_MMA(0, 1, At, B1); PG8_BAR; PG8_SCHED;
            PG8_LDA(At, 1, 1); PG8_STAGE(PG8_SB(1, 0), b3, wB); PG8_STAGE(PG8_SB(1, 1), b3 + hB2, wB); PG8_STAGE(PG8_SA(1, 0), a3, wA);
            PG8_WAIT_V(8); PG8_WAIT_L(0); PG8_BAR; PG8_MMA(1, 0, At, B0); PG8_MMA(1, 1, At, B1); PG8_BAR; PG8_SCHED;
        }
        if (wr == 0) PG8_BAR;
        E(acc, cur, wr, wc, fr, fq);
        if (!has_next) break;
#pragma unroll
        for (int a = 0; a < 2; ++a)
#pragma unroll
            for (int b = 0; b < 2; ++b)
#pragma unroll
                for (int m = 0; m < 4; ++m)
#pragma unroll
                    for (int n = 0; n < 2; ++n) acc[a][b][m][n] = (f32x4){0.f, 0.f, 0.f, 0.f};
        cur = nxt; cA = nA; cB = nB; hA = nhA; hB = nhB; vA[0] = nvA[0]; vA[1] = nvA[1]; vB[0] = nvB[0]; vB[1] = nvB[1]; ++ui;
        if (wr == 1) PG8_BAR;
    }
    PG8_WAIT_V(0);
    PG8_BAR;
#undef PG8_SA
#undef PG8_SB
#undef PG8_STAGE
#undef PG8_LDA
#undef PG8_LDB
#undef PG8_MMA
#undef PG8_WAIT_V
#undef PG8_WAIT_L
#undef PG8_BAR
#undef PG8_SCHED
#undef PG8_VOFF
}

struct SimpleSched {
    const char* A; const char* B; unsigned lda2, ldb2; int nt, nM, nN, G, c;
    __device__ __forceinline__ bool next(int i, GUnit& u) const {
        int pm, pn; if (!tile_order((long)i * G + c, nM, nN, pm, pn)) return false;
        u.A = A + (size_t)pm * 256 * lda2; u.B = B + (size_t)pn * 256 * ldb2; u.lda2 = lda2; u.ldb2 = ldb2; u.nt = nt; u.pm = pm; u.pn = pn; u.mode = 0; return true;
    }
};
struct ResSched {
    const char* A; const char* B; unsigned ld2; int nt, nchunk, nctx, G, c;
    __device__ __forceinline__ bool next(int i, GUnit& u) const {
        constexpr int TL = NPAN_LAT * 4;
        const long L = (long)i * G + c; int pm, pn;
        u.lda2 = ld2; u.ldb2 = ld2;
        if (L < TL) { tile_order(L, NPAN_LAT, 4, pm, pn); u.A = A + (size_t)pm * 256 * ld2; u.B = B + (size_t)pn * 256 * ld2; u.nt = nt; u.mode = 0; }
        else if (CTX_SPLITK) { const int x = (int)(L - TL); if (x >= nctx * nchunk) return false; const int tile = x / nchunk, ch = x - tile * nchunk; pm = NPAN_LAT + (tile >> 2); pn = tile & 3;
            u.A = A + (size_t)pm * 256 * ld2 + (size_t)ch * 512; u.B = B + (size_t)pn * 256 * ld2 + (size_t)ch * 512; u.nt = 4; u.mode = 1 + ch; }
        else { const int x = (int)(L - TL); if (x >= nctx) return false; pm = NPAN_LAT + (x >> 2); pn = x & 3; u.A = A + (size_t)pm * 256 * ld2; u.B = B + (size_t)pn * 256 * ld2; u.nt = nt; u.mode = 0; }
        u.pm = pm; u.pn = pn; return true;
    }
};
struct G1Sched {
    const char* H; const char* W1; int nM, G, c, nextra;
    __device__ __forceinline__ bool next(int i, GUnit& u) const {
        const long L = (long)i * G + c; int pm, pn;
        u.lda2 = 2048; u.ldb2 = 2048; u.nt = 16; u.mode = 0;
        if (L >= (long)nM * 15) { const int x = (int)(L - (long)nM * 15); if (x >= nextra) return false;
            pm = NPAN_LAT + x / 12; const int gt = x % 12; u.A = H + (size_t)pm * 256 * 2048; u.B = W1 + (size_t)(3840 + gt * 256) * 2048; u.pm = pm; u.pn = 15 + gt; return true; }
        if (!tile_order(L, nM, 15, pm, pn)) return false;
        const char* hp = H + (size_t)pm * 256 * 2048;
        if (pn < 13) { u.A = hp; u.B = W1 + (size_t)pn * 256 * 2048; } else { u.A = W1 + (size_t)(3328 + (pn - 13) * 256) * 2048; u.B = hp; }
        u.pm = pm; u.pn = pn; return true;
    }
};
struct G2Sched {
    const char* H; const char* W1; const char* OA; const char* WBR; int nM, G, c;
    __device__ __forceinline__ bool next(int i, GUnit& u) const {
        constexpr int TL = NPAN_LAT * 4;
        const int klat = (c < TL) ? (TL - c + G - 1) / G : 0;
        int pm, pn, sub;
        if (!CTX_GATES) { const int tile = i / 6; sub = i - tile * 6; if (!tile_order((long)tile * G + c, nM, 4, pm, pn)) return false; u.mode = sub; }
        else if (i < 6 * klat) { const int tile = i / 6; sub = i - tile * 6; tile_order((long)tile * G + c, NPAN_LAT, 4, pm, pn); u.mode = sub; }
        else { const int i2 = i - 6 * klat, k2 = i2 / 3; const int x = k2 * G + c; if (x >= (nM - NPAN_LAT) * 4) return false;
            pm = NPAN_LAT + (x >> 2); pn = x & 3; sub = 2 * (i2 - 3 * k2) + 1; u.mode = 8 + (sub >> 1); }
        const int br = sub >> 1;
        if ((sub & 1) == 0) { u.A = H + (size_t)pm * 256 * 2048; u.B = W1 + (size_t)(3840 + br * 1024 + pn * 256) * 2048; u.lda2 = 2048; u.ldb2 = 2048; u.nt = 16; }
        else { u.A = OA + (size_t)br * Z33 + (size_t)pm * 256 * 1024; u.B = WBR + (size_t)(br * 1024 + pn * 256) * 1024; u.lda2 = 1024; u.ldb2 = 1024; u.nt = 8; }
        u.pm = pm; u.pn = pn; return true;
    }
};

struct EpiG1 {
    static constexpr bool PERM = true;
    unsigned char* ws; const float* bgate;
    __device__ __forceinline__ void operator()(const f32x4 (&acc)[2][2][4][2], const GUnit& u, int wr, int wc, int fr, int fq) const {
        const int pn = u.pn;
        const unsigned row0 = (unsigned)(u.pm * 256 + wr * 64 + fr);
        const bool latent = u.pm < NPAN_LAT;
        unsigned char* wb = ws; OPAQUE_S(wb);
        if (pn >= 15) {
            const float* bg = bgate; OPAQUE_S(bg);
            const unsigned col0 = (unsigned)((pn - 15) * 256 + wc * 32 + 8 * fq);
            const unsigned lo = ((row0 - MLAT) * 3072u + col0) * 2u;
#pragma unroll
            for (int bj = 0; bj < 2; ++bj) { const f32x4 b0 = ld16f(bg + bj * 128, col0 * 4u), b1 = ld16f(bg + bj * 128 + 4, col0 * 4u);
#pragma unroll
                for (int ai = 0; ai < 2; ++ai)
#pragma unroll
                    for (int m = 0; m < 4; ++m) { f32x4 g0 = acc[ai][bj][m][0] + b0, g1 = acc[ai][bj][m][1] + b1;
#pragma unroll
                        for (int e = 0; e < 4; ++e) { g0[e] = fast_sigmoid(g0[e]); g1[e] = fast_sigmoid(g1[e]); }
                        st16(wb + WS_GATEC + ((ai * 128 + m * 16) * 3072 + bj * 128) * 2, lo, pack8(g0, g1)); } }
        } else if (pn == 2 || pn == 3) {
            const unsigned lo = ((row0 >> 3) * 512u + (row0 & 7) * 8u + (fq & 1) * 64u) * 2u;
#pragma unroll
            for (int bj = 0; bj < 2; ++bj) { const unsigned col = (unsigned)((pn - 2) * 256 + bj * 128 + wc * 32 + 8 * fq); const unsigned ho = ((col >> 6) * (unsigned)(MT * 64) + ((col >> 4) & 3) * 128u) * 2u;
#pragma unroll
                for (int ai = 0; ai < 2; ++ai)
#pragma unroll
                    for (int m = 0; m < 4; ++m) st16(wb + WS_KA + (ai * 128 + m * 16) * 64 * 2, lo + ho, pack8(acc[ai][bj][m][0], acc[ai][bj][m][1])); }
        } else if (pn < 2 || pn == 10 || pn == 11) {
            unsigned char* base = wb + (pn < 2 ? WS_QA : WS_CGB); const float sc = pn < 2 ? C2 : 1.f; const int colt = pn < 2 ? pn * 256 : (pn - 10) * 256;
            const unsigned lo = (row0 * 512u + (unsigned)(colt + wc * 32 + 8 * fq)) * 2u;
#pragma unroll
            for (int ai = 0; ai < 2; ++ai)
#pragma unroll
                for (int m = 0; m < 4; ++m)
#pragma unroll
                    for (int bj = 0; bj < 2; ++bj) st16(base + ((ai * 128 + m * 16) * 512 + bj * 128) * 2, lo, pack8(acc[ai][bj][m][0] * sc, acc[ai][bj][m][1] * sc));
        } else if (pn < 6 || (pn == 12 && wc < 2)) {
            const bool isq = pn < 6;
            unsigned char* base = wb + (isq ? WS_QB : WS_KB); const int head = isq ? (pn - 4) * 4 + wc : wc; const float sc = isq ? C2 : 1.f;
            const unsigned lo = isq ? (row0 * 512u + (unsigned)(head * 64 + 8 * fq)) * 2u
                                    : ((unsigned)head * (unsigned)(MT * 64) + (row0 >> 3) * 512u + (row0 & 7) * 8u + (fq >> 1) * 128u + (fq & 1) * 64u) * 2u;
            const unsigned rstride = isq ? 1024u : 128u, x2off = isq ? 64u : 512u;
            const unsigned t0 = (unsigned)((((u.pm & 31) * 256 + wr * 64 + fr) * 32 + 8 * fq) * 4);
#pragma unroll
            for (int ai = 0; ai < 2; ++ai)
#pragma unroll
                for (int m = 0; m < 4; ++m) {
                    f32x4 x1a = acc[ai][0][m][0], x1b = acc[ai][0][m][1], x2a = acc[ai][1][m][0], x2b = acc[ai][1][m][1];
                    f32x4 o1a = x1a, o1b = x1b, o2a = x2a, o2b = x2b;
                    if (latent) { const unsigned tc = (ai * 128 + m * 16) * 32 * 4;
                        const f32x4 ca = ld16f(wb + WS_COS + tc, t0), cb = ld16f(wb + WS_COS + tc + 16, t0), sa = ld16f(wb + WS_SIN + tc, t0), sb = ld16f(wb + WS_SIN + tc + 16, t0);
                        o1a = x1a * ca - x2a * sa; o1b = x1b * cb - x2b * sb; o2a = x1a * sa + x2a * ca; o2b = x1b * sb + x2b * cb; }
                    unsigned char* rb = base + (size_t)((ai * 128 + m * 16) * rstride);
                    st16(rb, lo, pack8(o1a * sc, o1b * sc)); st16(rb + x2off, lo, pack8(o2a * sc, o2b * sc)); asm volatile("" ::: "memory"); }
        } else if (pn < 10) {
            const unsigned lo = (row0 * 512u + (unsigned)((pn - 6) * 128 + wc * 32 + 8 * fq)) * 2u;
#pragma unroll
            for (int ai = 0; ai < 2; ++ai)
#pragma unroll
                for (int m = 0; m < 4; ++m) st16(wb + WS_U + (ai * 128 + m * 16) * 512 * 2, lo, pack8(acc[ai][0][m][0] * acc[ai][1][m][0], acc[ai][0][m][1] * acc[ai][1][m][1]));
        } else if (pn == 12) {
            const unsigned lo = ((row0 >> 3) * 512u + (unsigned)(((wc - 2) * 32 + 8 * fq) * 8) + (row0 & 7)) * 2u;
#pragma unroll
            for (int ai = 0; ai < 2; ++ai)
#pragma unroll
                for (int m = 0; m < 4; ++m)
#pragma unroll
                    for (int bj = 0; bj < 2; ++bj)
#pragma unroll
                        for (int n = 0; n < 2; ++n)
#pragma unroll
                            for (int e = 0; e < 4; ++e) st2(wb + WS_VBT + (size_t)bj * MT * 64 * 2 + ((4 * n + e) * 8 + (ai * 128 + m * 16) * 64) * 2, lo, f2bf(acc[ai][bj][m][n][e]));
        } else {
            const unsigned f0 = (unsigned)((pn - 13) * 256 + wr * 64 + fr);
            const unsigned lo = ((f0 >> 6) * (unsigned)(MT * 64) + (f0 & 63) * 8u + (unsigned)(u.pm * 32 + wc * 4 + fq) * 512u) * 2u;
#pragma unroll
            for (int ai = 0; ai < 2; ++ai)
#pragma unroll
                for (int m = 0; m < 4; ++m)
#pragma unroll
                    for (int bj = 0; bj < 2; ++bj) st16(wb + WS_VAT + (size_t)(ai * 2) * MT * 64 * 2 + (m * 128 + bj * 16 * 512) * 2, lo, pack8(acc[ai][bj][m][0], acc[ai][bj][m][1]));
        }
    }
};
struct EpiG2 {
    static constexpr bool PERM = true;
    unsigned char* ws; unsigned char* scr; const float* bgate;
    __device__ __forceinline__ void operator()(const f32x4 (&acc)[2][2][4][2], const GUnit& u, int wr, int wc, int fr, int fq) const {
        const bool cx = u.mode >= 8;
        const int sub = cx ? 2 * (u.mode - 8) + 1 : u.mode, br = sub >> 1;
        const unsigned tid16 = (unsigned)(((wr * 4 + wc) * 64 + fq * 16 + fr) * 16);
        unsigned char* wb = ws; unsigned char* sb = scr; const float* bg = bgate; OPAQUE_S(wb); OPAQUE_S(sb); OPAQUE_S(bg);
        if ((sub & 1) == 0) {
            const unsigned bo = (unsigned)((br * 1024 + u.pn * 256 + wc * 32 + 8 * fq) * 4);
            f32x4 bv[2][2];
#pragma unroll
            for (int bj = 0; bj < 2; ++bj)
#pragma unroll
                for (int n = 0; n < 2; ++n) bv[bj][n] = ld16f(bg + bj * 128 + 4 * n, bo);
#pragma unroll
            for (int ai = 0; ai < 2; ++ai)
#pragma unroll
                for (int bj = 0; bj < 2; ++bj)
#pragma unroll
                    for (int m = 0; m < 4; ++m) { f32x4 g0 = acc[ai][bj][m][0] + bv[bj][0], g1 = acc[ai][bj][m][1] + bv[bj][1];
#pragma unroll
                        for (int e = 0; e < 4; ++e) { g0[e] = fast_sigmoid(g0[e]); g1[e] = fast_sigmoid(g1[e]); }
                        st16(sb + ((ai * 2 + bj) * 4 + m) * 8192, tid16, pack8(g0, g1)); }
        } else {
            const unsigned rowl = (unsigned)(u.pm * 256 + wr * 64 + fr), coll = (unsigned)(u.pn * 256 + wc * 32 + 8 * fq);
            const unsigned mo = (rowl * 1024u + coll) * 2u;
            const unsigned go = cx ? ((rowl - MLAT) * 3072u + (unsigned)(br * 1024) + coll) * 2u : 0u;
            if (!cx) { if (br == 0) yepi<false, 0>(acc, wb, sb, tid16, go, mo); else if (br == 1) yepi<false, 1>(acc, wb, sb, tid16, go, mo); else yepi<false, 2>(acc, wb, sb, tid16, go, mo); }
            else     { if (br == 0) yepi<true, 0>(acc, wb, sb, tid16, go, mo);  else if (br == 1) yepi<true, 1>(acc, wb, sb, tid16, go, mo);  else yepi<true, 2>(acc, wb, sb, tid16, go, mo); }
        }
    }
    template <bool CX, int BR>
    static __device__ __forceinline__ void yepi(const f32x4 (&acc)[2][2][4][2], unsigned char* wb, unsigned char* sb, unsigned tid16, unsigned go, unsigned mo) {
#pragma unroll
        for (int ai = 0; ai < 2; ++ai)
#pragma unroll
            for (int bj = 0; bj < 2; ++bj)
#pragma unroll
                for (int m = 0; m < 4; ++m) { const unsigned k16 = ((ai * 2 + bj) * 4 + m) * 8192;
                    f32x4 g0, g1;
                    if (CX) unpack8(ld16(wb + WS_GATEC + ((ai * 128 + m * 16) * 3072 + bj * 128) * 2, go), g0, g1); else unpack8(ld16(sb + k16, tid16), g0, g1);
                    f32x4 v0 = g0 * acc[ai][bj][m][0], v1 = g1 * acc[ai][bj][m][1];
                    if (BR > 0) { f32x4 t0, t1; unpack8(ld16(sb + 131072 + k16, tid16), t0, t1); v0 += t0; v1 += t1; }
                    const u32x4 w = pack8(v0, v1);
                    if (BR < 2) st16(sb + 131072 + k16, tid16, w);
                    else st16(wb + WS_MERGED + ((ai * 128 + m * 16) * 1024 + bj * 128) * 2, mo, w);
                    asm volatile("" ::: "memory"); }
    }
};
struct EpiRes {
    static constexpr bool PERM = false;
    const float* base_lat; float* out_lat; float* xc; float* part; const float* mod; int goff;
    __device__ __forceinline__ void operator()(const f32x4 (&acc)[2][2][4][2], const GUnit& u, int wr, int wc, int fr, int fq) const {
        const int mode = __builtin_amdgcn_readfirstlane(u.mode), upm = __builtin_amdgcn_readfirstlane(u.pm);
        const bool latent = upm < NPAN_LAT;
        const int prow = latent ? upm : upm - NPAN_LAT;
        const float* base = latent ? base_lat : xc; float* out = latent ? out_lat : xc;
        if (mode != 0) out = (float*)((char*)part + (unsigned)(mode - 1) * (unsigned)(MCTX * D * 4));
        const float* gv = mod + (latent ? (upm >> 5) : 4) * 6144 + goff;
        OPAQUE_S(base); OPAQUE_S(out); OPAQUE_S(gv);
        const unsigned col0 = (unsigned)(u.pn * 256 + wc * 32 + 4 * fq);
        const unsigned lo = ((unsigned)(prow * 256 + wr * 64 + fr) * 1024u + col0) * 4u;
        f32x4 g[2][2];
#pragma unroll
        for (int bj = 0; bj < 2; ++bj)
#pragma unroll
            for (int n = 0; n < 2; ++n) g[bj][n] = ld16f(gv + bj * 128 + n * 16, col0 * 4u);
#pragma unroll
        for (int ai = 0; ai < 2; ++ai)
#pragma unroll
            for (int m = 0; m < 4; ++m) {
#pragma unroll
                for (int bj = 0; bj < 2; ++bj)
#pragma unroll
                    for (int n = 0; n < 2; ++n) { const unsigned oc = (ai * 128 + m * 16) * 1024 + bj * 128 + n * 16;
                        if (mode == 0) st16f(out + oc, lo, ld16f(base + oc, lo) + g[bj][n] * acc[ai][bj][m][n]);
                        else st16f(out + oc, lo, g[bj][n] * acc[ai][bj][m][n]); }
                if (m & 1) asm volatile("" ::: "memory"); }
    }
};
struct EpiSwiglu {
    static constexpr bool PERM = true;
    bf16_t* ACT;
    __device__ __forceinline__ void operator()(const f32x4 (&acc)[2][2][4][2], const GUnit& u, int wr, int wc, int fr, int fq) const {
        bf16_t* actb = ACT; OPAQUE_S(actb);
        const unsigned lo = ((unsigned)(u.pm * 256 + wr * 64 + fr) * (unsigned)DFF + (unsigned)(u.pn * 128 + wc * 32 + 8 * fq)) * 2u;
#pragma unroll
        for (int ai = 0; ai < 2; ++ai)
#pragma unroll
            for (int m = 0; m < 4; ++m) { f32x4 a0 = acc[ai][0][m][0], a1 = acc[ai][0][m][1];
#pragma unroll
                for (int e = 0; e < 4; ++e) { a0[e] = a0[e] * fast_sigmoid(a0[e]); a1[e] = a1[e] * fast_sigmoid(a1[e]); }
                st16(actb + (ai * 128 + m * 16) * DFF, lo, pack8(a0 * acc[ai][1][m][0], a1 * acc[ai][1][m][1])); }
    }
};
}

__device__ __forceinline__ int pi32(int m) { return (m & ~12) | ((m & 4) << 1) | ((m & 8) >> 1); }
struct KVF { bf16x8 k[4]; bf16x8 v[4]; };
__device__ __forceinline__ void kv_load(KVF& f, const bf16_t* Kt, const bf16_t* Vt, size_t key0, int koffl, int voffl) {
    const bf16_t* kp = Kt + (key0 >> 3) * 512 + koffl;
#pragma unroll
    for (int d0 = 0; d0 < 4; ++d0) f.k[d0] = *(const bf16x8*)(kp + 128 * d0);
    const bf16_t* vp = Vt + (key0 >> 3) * 512 + voffl;
    f.v[0] = *(const bf16x8*)(vp); f.v[1] = *(const bf16x8*)(vp + 1024); f.v[2] = *(const bf16x8*)(vp + 256); f.v[3] = *(const bf16x8*)(vp + 1280);
}
constexpr float RESC_THR = 8.0f;
__device__ __forceinline__ void attn_compute(const KVF& f, const bf16x8 (&qf)[4], f32x16 s, int maskmode, int r32, int hi, f32x16& o0, f32x16& o1, float& m, float& l) {
#pragma unroll
    for (int d0 = 0; d0 < 4; ++d0) s = __builtin_amdgcn_mfma_f32_32x32x16_bf16(f.k[d0], qf[d0], s, 0, 0, 0);
    if (maskmode != 0) {
#pragma unroll
        for (int r = 0; r < 16; ++r) { const int koff = 16 * (r >> 3) + 8 * hi + (r & 7); const bool ok = (maskmode == 1) ? (koff >= r32) : (koff <= r32); s[r] = ok ? s[r] : NEGBIG; }
    }
    float bm = fmaxf(fmaxf(s[0], s[1]), s[2]);
#pragma unroll
    for (int r = 3; r < 15; r += 2) bm = fmaxf(fmaxf(bm, s[r]), s[r + 1]);
    bm = fmaxf(bm, s[15]);
    bm = fmaxf(bm, __shfl_xor(bm, 32));
    if (__any(bm > m + RESC_THR)) {
        const float mn = fmaxf(m, bm);
        const float alpha = __builtin_amdgcn_exp2f(m - mn);
        m = mn; l *= alpha;
#pragma unroll
        for (int r = 0; r < 16; ++r) { o0[r] *= alpha; o1[r] *= alpha; }
    }
    float ps = 0.f;
#pragma unroll
    for (int r = 0; r < 16; ++r) { s[r] = __builtin_amdgcn_exp2f(s[r] - m); ps += s[r]; }
    l += ps;
    u32x4 w0, w1;
    w0.x = cvt_pk_bf16(s[0], s[1]); w0.y = cvt_pk_bf16(s[2], s[3]); w0.z = cvt_pk_bf16(s[4], s[5]); w0.w = cvt_pk_bf16(s[6], s[7]);
    w1.x = cvt_pk_bf16(s[8], s[9]); w1.y = cvt_pk_bf16(s[10], s[11]); w1.z = cvt_pk_bf16(s[12], s[13]); w1.w = cvt_pk_bf16(s[14], s[15]);
    const bf16x8 p0 = __builtin_bit_cast(bf16x8, w0), p1 = __builtin_bit_cast(bf16x8, w1);
    o0 = __builtin_amdgcn_mfma_f32_32x32x16_bf16(f.v[0], p0, o0, 0, 0, 0);
    o0 = __builtin_amdgcn_mfma_f32_32x32x16_bf16(f.v[1], p1, o0, 0, 0, 0);
    o1 = __builtin_amdgcn_mfma_f32_32x32x16_bf16(f.v[2], p0, o1, 0, 0, 0);
    o1 = __builtin_amdgcn_mfma_f32_32x32x16_bf16(f.v[3], p1, o1, 0, 0, 0);
}
__device__ __forceinline__ void attn_finish(bf16_t* orow, const f32x16& o0, const f32x16& o1, float l, int hi) {
    const float lt = l + __shfl_xor(l, 32);
    const float inv = 1.0f / lt;
#pragma unroll
    for (int g = 0; g < 4; ++g) {
        u32x2 a, b;
        a.x = cvt_pk_bf16(o0[4 * g] * inv, o0[4 * g + 1] * inv); a.y = cvt_pk_bf16(o0[4 * g + 2] * inv, o0[4 * g + 3] * inv);
        b.x = cvt_pk_bf16(o1[4 * g] * inv, o1[4 * g + 1] * inv); b.y = cvt_pk_bf16(o1[4 * g + 2] * inv, o1[4 * g + 3] * inv);
        *(u32x2*)(orow + 8 * g + 4 * hi) = a; *(u32x2*)(orow + 32 + 8 * g + 4 * hi) = b;
    }
}
__device__ __forceinline__ f32x16 zero16() { f32x16 z;
#pragma unroll
    for (int r = 0; r < 16; ++r) z[r] = 0.f;
    return z; }
__device__ __forceinline__ f32x16 load16(const float* p) { const f32x4 a = *(const f32x4*)p, b = *(const f32x4*)(p + 256), c = *(const f32x4*)(p + 512), d = *(const f32x4*)(p + 768);
    f32x16 z; z[0] = a[0]; z[1] = a[1]; z[2] = a[2]; z[3] = a[3]; z[4] = b[0]; z[5] = b[1]; z[6] = b[2]; z[7] = b[3]; z[8] = c[0]; z[9] = c[1]; z[10] = c[2]; z[11] = c[3]; z[12] = d[0]; z[13] = d[1]; z[14] = d[2]; z[15] = d[3]; return z; }

__device__ __forceinline__ void attn_ctx_blocks(const bf16_t* Kt, const bf16_t* Vt, size_t key0, const bf16x8 (&qf)[4], int koffl, int voffl, int r32, int hi, f32x16& o0, f32x16& o1, float& m, float& l) {
    KVF fa, fb;
    kv_load(fa, Kt, Vt, key0, koffl, voffl);
#pragma unroll 1
    for (int kb = 0; kb < 8; kb += 2) {
        kv_load(fb, Kt, Vt, key0 + (kb + 1) * 32, koffl, voffl);
        attn_compute(fa, qf, zero16(), 0, r32, hi, o0, o1, m, l);
        if (kb + 2 < 8) kv_load(fa, Kt, Vt, key0 + (kb + 2) * 32, koffl, voffl);
        attn_compute(fb, qf, zero16(), 0, r32, hi, o0, o1, m, l);
    }
}
struct AttnPtrs { bf16_t* QA; const bf16_t* KA; const bf16_t* VAT; bf16_t* QB; const bf16_t* KB; const bf16_t* VBT; const float* CT; const float* sink; };
#define ATTN_LANE() const int r32 = lane & 31, hi = lane >> 5; const int kp_ = pi32(r32); const int koffl = (kp_ >> 3) * 512 + hi * 64 + (kp_ & 7) * 8, voffl = hi * 512 + r32 * 8

__device__ __forceinline__ void na_task(const AttnPtrs& P, int l, int b, int h, int r, int half, int lane, bf16_t* oalt) {
    ATTN_LANE();
    const size_t qrow = (size_t)b * SEQ + r * 64 + half * 32 + r32;
    bf16_t* qp = P.QA + qrow * 512 + h * 64;
    bf16x8 qf[4];
#pragma unroll
    for (int d0 = 0; d0 < 4; ++d0) qf[d0] = *(const bf16x8*)(qp + d0 * 16 + hi * 8);
    f32x16 o0 = zero16(), o1 = zero16(); float m = -1e30f, lsum = 0.f;
    const bf16_t* Kh = P.KA + (size_t)h * MT * 64; const bf16_t* Vh = P.VAT + (size_t)h * MT * 64;
    attn_ctx_blocks(Kh, Vh, (size_t)(MLAT + b * CTXL), qf, koffl, voffl, r32, hi, o0, o1, m, lsum);
    const int r0 = min(max(r - 4, 0), 120);
    const float* ctb = P.CT + ((size_t)((l * 8 + h) * 15 + (r0 - r + 7)) * 4 + half * 2) * 1024 + lane * 4;
    const size_t key00 = (size_t)b * SEQ + r0 * 64;
    KVF fa, fb; f32x16 ca, cb;
    kv_load(fa, Kh, Vh, key00, koffl, voffl); ca = load16(ctb);
#pragma unroll 1
    for (int j = 0; j < 16; j += 2) {
        kv_load(fb, Kh, Vh, key00 + (j + 1) * 32, koffl, voffl); cb = load16(ctb + (size_t)((j >> 1) * 4 + 1) * 1024);
        attn_compute(fa, qf, ca, 0, r32, hi, o0, o1, m, lsum);
        if (j + 2 < 16) { kv_load(fa, Kh, Vh, key00 + (j + 2) * 32, koffl, voffl); ca = load16(ctb + (size_t)(((j + 2) >> 1) * 4) * 1024); }
        attn_compute(fb, qf, cb, 0, r32, hi, o0, o1, m, lsum);
    }
    attn_finish(oalt ? oalt + qrow * 512 + h * 64 : qp, o0, o1, lsum, hi);
}
__device__ __forceinline__ void swa_task(const AttnPtrs& P, int l, int b, int h, int qblk, int lane, bf16_t* oalt) {
    ATTN_LANE();
    const int g = h >> 2;
    const size_t qrow = (size_t)b * SEQ + qblk * 32 + r32;
    bf16_t* qp = P.QB + qrow * 512 + h * 64;
    bf16x8 qf[4];
#pragma unroll
    for (int d0 = 0; d0 < 4; ++d0) qf[d0] = *(const bf16x8*)(qp + d0 * 16 + hi * 8);
    f32x16 o0 = zero16(), o1 = zero16(); float m = P.sink[l * 8 + h] * LOG2E, lsum = (hi == 0) ? 1.f : 0.f;
    const bf16_t* Kh = P.KB + (size_t)g * MT * 64; const bf16_t* Vh = P.VBT + (size_t)g * MT * 64;
    attn_ctx_blocks(Kh, Vh, (size_t)(MLAT + b * CTXL), qf, koffl, voffl, r32, hi, o0, o1, m, lsum);
    const int jlo = (qblk < 4) ? (4 - qblk) : 0, jhi = (qblk > 251) ? (255 - qblk + 4) : 8;
    const int kb0 = b * SEQ + (qblk - 4) * 32;
    KVF fa, fb;
    kv_load(fa, Kh, Vh, (size_t)(kb0 + jlo * 32), koffl, voffl);
#pragma unroll 1
    for (int j = jlo; j <= jhi; j += 2) {
        if (j + 1 <= jhi) kv_load(fb, Kh, Vh, (size_t)(kb0 + (j + 1) * 32), koffl, voffl);
        attn_compute(fa, qf, zero16(), (j == 0) ? 1 : ((j == 8) ? 2 : 0), r32, hi, o0, o1, m, lsum);
        if (j + 2 <= jhi) kv_load(fa, Kh, Vh, (size_t)(kb0 + (j + 2) * 32), koffl, voffl);
        if (j + 1 <= jhi) attn_compute(fb, qf, zero16(), (j + 1 == 8) ? 2 : 0, r32, hi, o0, o1, m, lsum);
    }
    attn_finish(oalt ? oalt + qrow * 512 + h * 64 : qp, o0, o1, lsum, hi);
}
__device__ __forceinline__ void ctx_task(const AttnPtrs& P, int l, int typ, int b, int h, int qblk, int lane, bf16_t* oalt) {
    ATTN_LANE();
    const size_t qrow = (size_t)MLAT + b * CTXL + qblk * 32 + r32;
    bf16_t* qp = (typ == 0 ? P.QA : P.QB) + qrow * 512 + h * 64;
    bf16x8 qf[4];
#pragma unroll
    for (int d0 = 0; d0 < 4; ++d0) qf[d0] = *(const bf16x8*)(qp + d0 * 16 + hi * 8);
    f32x16 o0 = zero16(), o1 = zero16(); float m, lsum;
    if (typ == 0) { m = -1e30f; lsum = 0.f;
        attn_ctx_blocks(P.KA + (size_t)h * MT * 64, P.VAT + (size_t)h * MT * 64, (size_t)(MLAT + b * CTXL), qf, koffl, voffl, r32, hi, o0, o1, m, lsum); }
    else { const int g = h >> 2; m = P.sink[l * 8 + h] * LOG2E; lsum = (hi == 0) ? 1.f : 0.f;
        attn_ctx_blocks(P.KB + (size_t)g * MT * 64, P.VBT + (size_t)g * MT * 64, (size_t)(MLAT + b * CTXL), qf, koffl, voffl, r32, hi, o0, o1, m, lsum); }
    attn_finish(oalt ? oalt + qrow * 512 + h * 64 : qp, o0, o1, lsum, hi);
}

__device__ __forceinline__ void transpose_item(const float* W, int K, int N, bf16_t* WT, int ncol0, int nrow0, int k0, LAS float* scr, int lane) {
#pragma unroll 8
    for (int i = 0; i < 32; ++i) { const int kk = 2 * i + (lane >> 5); scr[kk * 33 + (lane & 31)] = W[(size_t)(k0 + kk) * N + ncol0 + (lane & 31)]; }
    LDS_WAIT(); asm volatile("" ::: "memory");
    const int c = lane & 7;
#pragma unroll
    for (int j = 0; j < 4; ++j) { const int n = (lane >> 3) + 8 * j; const LAS float* s = scr + (8 * c) * 33 + n;
        u32x4 o; o.x = cvt_pk_bf16(s[0 * 33], s[1 * 33]); o.y = cvt_pk_bf16(s[2 * 33], s[3 * 33]); o.z = cvt_pk_bf16(s[4 * 33], s[5 * 33]); o.w = cvt_pk_bf16(s[6 * 33], s[7 * 33]);
        *(u32x4*)(WT + (size_t)(nrow0 + n) * K + k0 + 8 * c) = o; }
    LDS_WAIT(); asm volatile("" ::: "memory");
}
__device__ __forceinline__ int srcmap1(int n) {
    if (n < 1024) return n;
    if (n < 1536) { const int t = (n - 1024) >> 8, j = (n - 1024) & 255, half = j >> 7, jj = j & 127; return 1536 + (t * 4 + (jj >> 5)) * 64 + half * 32 + (jj & 31); }
    if (n < 2560) { const int t = (n - 1536) >> 8, j = (n - 1536) & 255, half = j >> 7, jj = j & 127; return (half ? 3328 : 2304) + t * 128 + jj; }
    if (n < 3072) return 2816 + (n - 2560);
    if (n < 3328) { const int j = n - 3072, half = j >> 7, jj = j & 127; if (jj < 64) return 2048 + (jj >> 5) * 64 + half * 32 + (jj & 31); return 2176 + half * 64 + (jj - 64); }
    if (n < 3840) return 1024 + (n - 3328);
    return n;
}
__device__ __forceinline__ int srcmap4(int n) { const int t = n >> 8, j = n & 255; return (j >> 7) * DFF + t * 128 + (j & 127); }

struct Args { const float* in[20]; float* out; unsigned char* ws; int ph_lo, ph_hi; };
constexpr int NPHASE = 2 + 8 * DEPTH;

__global__ void __launch_bounds__(NWAVES * 64, 2) fwd_kernel(Args args) {
    extern __shared__ __attribute__((aligned(16))) unsigned char lds_raw[];
    LAS unsigned char* lds = (LAS unsigned char*)lds_raw;
    const int G = gridDim.x, bx = blockIdx.x;
    const int vcu = (G % 8 == 0) ? (bx % 8) * (G / 8) + bx / 8 : bx;
    const int NGW = G * NWAVES;
#define PHASE_IDS() const int tid = opaque_tid(); const int lane = tid & 63, wave = __builtin_amdgcn_readfirstlane(tid >> 6); const int gw = vcu * NWAVES + wave; (void)lane; (void)gw
    unsigned char* ws = args.ws;
    unsigned* ctl = (unsigned*)(ws + WS_CTL);
    const float* x_in = args.in[0]; const float* c_in = args.in[1]; const float* ctx_in = args.in[2]; const float* cctx_in = args.in[3];
    const float* w_ada = args.in[4]; const float* b_ada = args.in[5]; const float* norm1_g = args.in[6]; const float* norm2_g = args.in[7];
    const float* w_in = args.in[8]; const float* b_gate = args.in[9]; const float* na_rpb = args.in[10]; const float* sw_sink = args.in[11];
    const float* conv_w = args.in[12]; const float* w_br_a = args.in[13]; const float* w_br_b = args.in[14]; const float* w_br_c = args.in[15];
    const float* w_o = args.in[16]; const float* w_up = args.in[17]; const float* w_down = args.in[18]; const float* final_g = args.in[19];
    float* out = args.out;
    float* MOD = (float*)(ws + WS_MOD); float* COS = (float*)(ws + WS_COS); float* SIN = (float*)(ws + WS_SIN); float* CT = (float*)(ws + WS_CT);
    bf16_t* WB = (bf16_t*)(ws + WS_W); bf16_t* H = (bf16_t*)(ws + WS_H); float* XC = (float*)(ws + WS_XC);
    bf16_t* QA = (bf16_t*)(ws + WS_QA); bf16_t* KA = (bf16_t*)(ws + WS_KA); bf16_t* VAT = (bf16_t*)(ws + WS_VAT); bf16_t* QB = (bf16_t*)(ws + WS_QB);
    bf16_t* U = (bf16_t*)(ws + WS_U); bf16_t* CGB = (bf16_t*)(ws + WS_CGB); bf16_t* KB = (bf16_t*)(ws + WS_KB); bf16_t* VBT = (bf16_t*)(ws + WS_VBT);
    bf16_t* MERGED = (bf16_t*)(ws + WS_MERGED); bf16_t* ACT = (bf16_t*)(ws + WS_ACT); bf16_t* GATEC = (bf16_t*)(ws + WS_GATEC);

    for (int u = threadIdx.x; u < (LDS_BYTES - LDSCTL_OFF) / 4; u += NWAVES * 64) ((LAS unsigned*)(lds + LDSCTL_OFF))[u] = 0u;
    __syncthreads();
    volatile LAS unsigned* MISC = (volatile LAS unsigned*)(lds + MISC_OFF);
    XcdBarrier bar; bar.bar = ctl + CW_BAR; bar.x = 0; bar.st = nullptr;
#if MK_SINGLE
    bar = xcd_barrier_post(ctl + CW_BAR, MISC + 8);
#endif
    const int lo = args.ph_lo, hi_ph = args.ph_hi;
#define IN(k) (lo <= (k) && (k) < hi_ph)
#define SEAM(k) do { if (IN(k) && IN((k) + 1)) xcd_barrier(bar); } while (0)

    if (IN(0)) {
        PHASE_IDS();
        LAS float* scr = (LAS float*)(lds + RING_OFF + wave * 16384);
        constexpr int I_W1 = (NIN / 32) * (D / 64), I_BR = (D / 32) * (512 / 64), I_WO = (D / 32) * (D / 64), I_W4 = (2 * DFF / 32) * (D / 64), I_W5 = (D / 32) * (DFF / 64);
        constexpr int I_LAYER = I_W1 + 3 * I_BR + I_WO + I_W4 + I_W5;
        for (int it = gw; it < DEPTH * I_LAYER; it += NGW) {
            const int l = it / I_LAYER; int r = it - l * I_LAYER;
            bf16_t* wl = WB + (size_t)l * W_LAYER_ELEMS;
            if (r < I_W1) { const int kb = r / (NIN / 32), nb = r % (NIN / 32); transpose_item(w_in + (size_t)l * D * NIN, D, NIN, wl + WO_W1, srcmap1(nb * 32), nb * 32, kb * 64, scr, lane); continue; } r -= I_W1;
            if (r < 3 * I_BR) { const int br = r / I_BR, rr = r % I_BR, kb = rr / (D / 32), nb = rr % (D / 32); const float* src = (br == 0 ? w_br_a : (br == 1 ? w_br_b : w_br_c)) + (size_t)l * 512 * D;
                transpose_item(src, 512, D, wl + WO_WBR + (size_t)br * D * 512, nb * 32, nb * 32, kb * 64, scr, lane); continue; } r -= 3 * I_BR;
            if (r < I_WO) { const int kb = r / (D / 32), nb = r % (D / 32); transpose_item(w_o + (size_t)l * D * D, D, D, wl + WO_WO, nb * 32, nb * 32, kb * 64, scr, lane); continue; } r -= I_WO;
            if (r < I_W4) { const int kb = r / (2 * DFF / 32), nb = r % (2 * DFF / 32); transpose_item(w_up + (size_t)l * D * 2 * DFF, D, 2 * DFF, wl + WO_W4, srcmap4(nb * 32), nb * 32, kb * 64, scr, lane); continue; } r -= I_W4;
            { const int kb = r / (D / 32), nb = r % (D / 32); transpose_item(w_down + (size_t)l * DFF * D, DFF, D, wl + WO_W5, nb * 32, nb * 32, kb * 64, scr, lane); }
        }
        __syncthreads();
        {
            LAS float* sl = (LAS float*)(lds + RING_OFF);
            LAS float* red = (LAS float*)(lds + RING_OFF + 32768);
            for (int i = tid; i < 5 * D; i += NWAVES * 64) { const int bi = i >> 10, k = i & 1023; const float v = (bi < 4) ? c_in[bi * D + k] : cctx_in[k]; sl[i] = v / (1.0f + __expf(-v)); }
            __syncthreads();
            for (int it = bx; it < DEPTH * 96; it += G) {
                const int l = it / 96, n = (it % 96) * 64 + lane;
                const float* wp = w_ada + ((size_t)l * D + wave * 128) * 6144 + n;
                float a0 = 0.f, a1 = 0.f, a2 = 0.f, a3 = 0.f, a4 = 0.f;
#pragma unroll 8
                for (int k = 0; k < 128; ++k) { const float w = wp[(size_t)k * 6144]; const int kk = wave * 128 + k;
                    a0 += sl[kk] * w; a1 += sl[1024 + kk] * w; a2 += sl[2048 + kk] * w; a3 += sl[3072 + kk] * w; a4 += sl[4096 + kk] * w; }
                red[(wave * 5 + 0) * 64 + lane] = a0; red[(wave * 5 + 1) * 64 + lane] = a1; red[(wave * 5 + 2) * 64 + lane] = a2; red[(wave * 5 + 3) * 64 + lane] = a3; red[(wave * 5 + 4) * 64 + lane] = a4;
                __syncthreads();
                if (tid < 320) { const int bi = tid >> 6, ln = tid & 63; float s = b_ada[l * 6144 + (it % 96) * 64 + ln];
#pragma unroll
                    for (int w = 0; w < 8; ++w) s += red[(w * 5 + bi) * 64 + ln];
                    MOD[((size_t)l * 5 + bi) * 6144 + (it % 96) * 64 + ln] = s; }
                __syncthreads();
            }
        }
        for (int i = gw * 64 + lane; i < MCTX * D / 4; i += NGW * 64) ((f32x4*)XC)[i] = ((const f32x4*)ctx_in)[i];
        for (int i = gw * 64 + lane; i < SEQ * 32; i += NGW * 64) { const int t = i >> 5, p = i & 31; const float pos = (p < 16) ? (float)(t >> 6) : (float)(t & 63);
            const float inv = powf(10000.0f, -(float)(p & 15) / 16.0f); const float ang = pos * inv; COS[i] = cosf(ang); SIN[i] = sinf(ang); }
        for (int i = gw * 64 + lane; i < DEPTH * 8 * 15 * 4 * 1024; i += NGW * 64) {
            const int r = ((i >> 8) & 3) * 4 + (i & 3), ln = (i >> 2) & 63, kb = (i >> 10) & 1, qb = (i >> 11) & 1; const int rest = i >> 12; const int drow = rest % 15, lh = rest / 15;
            const int q32 = ln & 31, hh = ln >> 5; const int koff = 16 * (r >> 3) + 8 * hh + (r & 7); const int kc = kb * 32 + koff, c = qb * 32 + q32;
            const int c0 = min(max(c - 8, 0), 48); const bool ok = (kc >= c0) && (kc < c0 + 16);
            CT[i] = ok ? na_rpb[((size_t)lh * 15 + drow) * 31 + (kc - c + 15)] * LOG2E : NEGBIG;
        }
    }
    SEAM(0);

    for (int l = 0; l < DEPTH; ++l) {
        const int P = 1 + 8 * l;
        const bool lastl = (l == DEPTH - 1);
        const float* modl = MOD + (size_t)l * 5 * 6144;
        const bf16_t* wl = WB + (size_t)l * W_LAYER_ELEMS;
        const float* xlat = (l == 0) ? x_in : out;
        const float* xctx = XC;
        if (IN(P + 0)) {
            PHASE_IDS();
            const int npart1 = (l == 0 || !CTX_SPLITK) ? 0 : 11;
            for (int row = gw; row < MT; row += NGW) {
                const bool latent = row < MLAT; const float* xr = latent ? xlat + (size_t)row * D : xctx + (size_t)(row - MLAT) * D;
                const float* mv = modl + (latent ? (row >> 13) : 4) * 6144; const float* gp = norm1_g + l * D;
                f32x4 v[4]; float ss = 0.f;
#pragma unroll
                for (int j = 0; j < 4; ++j) v[j] = *(const f32x4*)(xr + 256 * j + 4 * lane);
                if (!latent && npart1 > 0) { const float* pp = (const float*)(ws + WS_SCR) + (size_t)(row - MLAT) * D + 4 * lane;
                    for (int ch = 0; ch < npart1; ++ch)
#pragma unroll
                        for (int j = 0; j < 4; ++j) v[j] += *(const f32x4*)(pp + (size_t)ch * MCTX * D + 256 * j);
#pragma unroll
                    for (int j = 0; j < 4; ++j) *(f32x4*)(XC + (size_t)(row - MLAT) * D + 256 * j + 4 * lane) = v[j]; }
#pragma unroll
                for (int j = 0; j < 4; ++j) { ss += (v[j][0] * v[j][0] + v[j][1] * v[j][1]) + (v[j][2] * v[j][2] + v[j][3] * v[j][3]); }
                const float rinv = 1.0f / sqrtf(wave_sum(ss) * (1.0f / D) + NORM_EPS);
#pragma unroll
                for (int j = 0; j < 4; ++j) { const int c = 256 * j + 4 * lane; const f32x4 g = *(const f32x4*)(gp + c), sh = *(const f32x4*)(mv + c), sc = *(const f32x4*)(mv + 1024 + c);
                    const f32x4 y = (v[j] * rinv * g) * (1.0f + sc) + sh; u32x2 w; w.x = cvt_pk_bf16(y[0], y[1]); w.y = cvt_pk_bf16(y[2], y[3]); *(u32x2*)(H + (size_t)row * D + c) = w; }
            }
        }
        SEAM(P + 0);
        if (IN(P + 1)) {
            pg8::G1Sched S{(const char*)H, (const char*)(wl + WO_W1), NPAN, G, bx, (lastl || !CTX_GATES) ? 0 : 48};
            pg8::EpiG1 E{ws, b_gate + (size_t)l * 3072};
            pg8::gemm_phase<pg8::EpiG1, pg8::G1Sched>(lds + RING_OFF, S, E);
            if (PROBE_DUP & (1 << 1)) pg8::gemm_phase<pg8::EpiG1, pg8::G1Sched>(lds + RING_OFF, S, E);
        }
        SEAM(P + 1);
        if (IN(P + 2)) {
            PHASE_IDS();
            AttnPtrs AP{QA, KA, VAT, QB, KB, VBT, CT, sw_sink};
            if (PROBE_DUP & (1 << 2)) {
                bf16_t* dump = (bf16_t*)(ws + WS_SCR);
                for (int t = gw; t < NBATCH * 8 * 256; t += NGW) { const int bh = t >> 8, r = (t >> 1) & 127, half = t & 1; na_task(AP, l, bh >> 3, bh & 7, r, half, lane, dump); }
                for (int t = gw; t < NBATCH * 8 * 256; t += NGW) { const int bh = t >> 8, qblk = t & 255; swa_task(AP, l, bh >> 3, bh & 7, qblk, lane, dump); }
                if (!lastl) for (int t = gw; t < 2 * NBATCH * 8 * 8; t += NGW) { const int typ = t >> 8, bh = (t >> 3) & 31, qblk = t & 7; ctx_task(AP, l, typ, bh >> 3, bh & 7, qblk, lane, dump); }
            }
            for (int t = gw; t < NBATCH * 8 * 256; t += NGW) { const int bh = t >> 8, r = (t >> 1) & 127, half = t & 1; na_task(AP, l, bh >> 3, bh & 7, r, half, lane, nullptr); }
            for (int t = gw; t < NBATCH * 8 * 256; t += NGW) { const int bh = t >> 8, qblk = t & 255; swa_task(AP, l, bh >> 3, bh & 7, qblk, lane, nullptr); }
            if (!lastl) for (int t = gw; t < 2 * NBATCH * 8 * 8; t += NGW) { const int typ = t >> 8, bh = (t >> 3) & 31, qblk = t & 7; ctx_task(AP, l, typ, bh >> 3, bh & 7, qblk, lane, nullptr); }
            const int nrows = lastl ? MLAT : MT;
            const float* cw = conv_w + (size_t)l * 3 * 512;
            for (int it = gw * 64 + lane; it < nrows * 64; it += NGW * 64) {
                const int row = it >> 6, ch = (it & 63) * 8;
                const bool latent = row < MLAT; const int tl = latent ? (row & (SEQ - 1)) : ((row - MLAT) & (CTXL - 1)); const int tmax = latent ? SEQ - 1 : CTXL - 1;
                const u32x4 zero = {0u, 0u, 0u, 0u};
                const u32x4 um = (tl > 0) ? *(const u32x4*)(U + (size_t)(row - 1) * 512 + ch) : zero;
                const u32x4 uc = *(const u32x4*)(U + (size_t)row * 512 + ch);
                const u32x4 up = (tl < tmax) ? *(const u32x4*)(U + (size_t)(row + 1) * 512 + ch) : zero;
                const u32x4 gb = *(const u32x4*)(CGB + (size_t)row * 512 + ch);
                f32x4 m0, m1, c0, c1, p0, p1, g0, g1; unpack8(um, m0, m1); unpack8(uc, c0, c1); unpack8(up, p0, p1); unpack8(gb, g0, g1);
                const f32x4 w00 = *(const f32x4*)(cw + ch), w01 = *(const f32x4*)(cw + ch + 4), w10 = *(const f32x4*)(cw + 512 + ch), w11 = *(const f32x4*)(cw + 512 + ch + 4), w20 = *(const f32x4*)(cw + 1024 + ch), w21 = *(const f32x4*)(cw + 1024 + ch + 4);
                const f32x4 y0 = g0 * (w00 * m0 + w10 * c0 + w20 * p0), y1 = g1 * (w01 * m1 + w11 * c1 + w21 * p1);
                *(u32x4*)(CGB + (size_t)row * 512 + ch) = pack8(y0, y1);
            }
        }
        SEAM(P + 2);
        const int nMl = lastl ? NPAN_LAT : NPAN;
        if (IN(P + 3)) {
            pg8::G2Sched S{(const char*)H, (const char*)(wl + WO_W1), (const char*)QA, (const char*)(wl + WO_WBR), nMl, G, bx};
            pg8::EpiG2 E{ws, ws + WS_SCR + (size_t)bx * 262144, b_gate + (size_t)l * 3072};
            pg8::gemm_phase<pg8::EpiG2, pg8::G2Sched>(lds + RING_OFF, S, E);
            if (PROBE_DUP & (1 << 3)) pg8::gemm_phase<pg8::EpiG2, pg8::G2Sched>(lds + RING_OFF, S, E);
        }
        SEAM(P + 3);
        if (IN(P + 4)) {
            pg8::ResSched S{(const char*)MERGED, (const char*)(wl + WO_WO), 2048, 16, 4, lastl ? 0 : 16, G, bx};
            pg8::EpiRes E{xlat, out, XC, (float*)(ws + WS_SCR), modl, 2048};
            pg8::gemm_phase<pg8::EpiRes, pg8::ResSched>(lds + RING_OFF, S, E);
        }
        SEAM(P + 4);
        if (IN(P + 5)) {
            PHASE_IDS();
            const int nrows = lastl ? MLAT : MT;
            for (int row = gw; row < nrows; row += NGW) {
                const bool latent = row < MLAT; const float* xr = latent ? out + (size_t)row * D : XC + (size_t)(row - MLAT) * D;
                const float* mv = modl + (latent ? (row >> 13) : 4) * 6144 + 3072; const float* gp = norm2_g + l * D;
                f32x4 v[4]; float ss = 0.f;
#pragma unroll
                for (int j = 0; j < 4; ++j) v[j] = *(const f32x4*)(xr + 256 * j + 4 * lane);
                if (!latent && CTX_SPLITK) { const float* pp = (const float*)(ws + WS_SCR) + (size_t)(row - MLAT) * D + 4 * lane;
                    for (int ch = 0; ch < 4; ++ch)
#pragma unroll
                        for (int j = 0; j < 4; ++j) v[j] += *(const f32x4*)(pp + (size_t)ch * MCTX * D + 256 * j);
#pragma unroll
                    for (int j = 0; j < 4; ++j) *(f32x4*)(XC + (size_t)(row - MLAT) * D + 256 * j + 4 * lane) = v[j]; }
#pragma unroll
                for (int j = 0; j < 4; ++j) { ss += (v[j][0] * v[j][0] + v[j][1] * v[j][1]) + (v[j][2] * v[j][2] + v[j][3] * v[j][3]); }
                const float rinv = 1.0f / sqrtf(wave_sum(ss) * (1.0f / D) + NORM_EPS);
#pragma unroll
                for (int j = 0; j < 4; ++j) { const int c = 256 * j + 4 * lane; const f32x4 g = *(const f32x4*)(gp + c), sh = *(const f32x4*)(mv + c), sc = *(const f32x4*)(mv + 1024 + c);
                    const f32x4 y = (v[j] * rinv * g) * (1.0f + sc) + sh; u32x2 w; w.x = cvt_pk_bf16(y[0], y[1]); w.y = cvt_pk_bf16(y[2], y[3]); *(u32x2*)(H + (size_t)row * D + c) = w; }
            }
        }
        SEAM(P + 5);
        if (IN(P + 6)) {
            pg8::SimpleSched S{(const char*)H, (const char*)(wl + WO_W4), 2048, 2048, 16, nMl, 22, G, bx};
            pg8::EpiSwiglu E{ACT};
            pg8::gemm_phase<pg8::EpiSwiglu, pg8::SimpleSched>(lds + RING_OFF, S, E);
            if (PROBE_DUP & (1 << 6)) pg8::gemm_phase<pg8::EpiSwiglu, pg8::SimpleSched>(lds + RING_OFF, S, E);
        }
        SEAM(P + 6);
        if (IN(P + 7)) {
            pg8::ResSched S{(const char*)ACT, (const char*)(wl + WO_W5), 2 * DFF, DFF / 64, 11, lastl ? 0 : 16, G, bx};
            pg8::EpiRes E{out, out, XC, (float*)(ws + WS_SCR), modl, 5120};
            pg8::gemm_phase<pg8::EpiRes, pg8::ResSched>(lds + RING_OFF, S, E);
        }
        SEAM(P + 7);
    }
    if (IN(NPHASE - 1)) {
        PHASE_IDS();
        for (int row = gw; row < MLAT; row += NGW) {
            float* xr = out + (size_t)row * D;
            f32x4 v[4]; float ss = 0.f;
#pragma unroll
            for (int j = 0; j < 4; ++j) { v[j] = *(const f32x4*)(xr + 256 * j + 4 * lane); ss += (v[j][0] * v[j][0] + v[j][1] * v[j][1]) + (v[j][2] * v[j][2] + v[j][3] * v[j][3]); }
            const float rinv = 1.0f / sqrtf(wave_sum(ss) * (1.0f / D) + NORM_EPS);
#pragma unroll
            for (int j = 0; j < 4; ++j) { const int c = 256 * j + 4 * lane; const f32x4 g = *(const f32x4*)(final_g + c); *(f32x4*)(xr + c) = v[j] * rinv * g; }
        }
    }
#undef IN
#undef SEAM
}

extern "C" void kernel_launch(void* const* d_in, const int* in_sizes, int n_in, void* d_out, int out_size, void* d_ws, size_t ws_size, hipStream_t stream) {
    static int grid = 0;
    if (grid == 0) {
        if (n_in != 20 || in_sizes[0] != MLAT * D || out_size != MLAT * D || ws_size < WS_END) {
            fprintf(stderr, "kernel_launch: unexpected shapes: n_in %d in0 %d out %d ws %zu (need %zu); nothing launched\n", n_in, n_in > 0 ? in_sizes[0] : -1, out_size, ws_size, (size_t)WS_END); grid = -1; return; }
        int dev = 0, cus = 0, per_cu = 0;
        if (hipGetDevice(&dev) != hipSuccess || hipDeviceGetAttribute(&cus, hipDeviceAttributeMultiprocessorCount, dev) != hipSuccess) { fprintf(stderr, "kernel_launch: device query failed\n"); grid = -1; return; }
        if (hipFuncSetAttribute((const void*)fwd_kernel, hipFuncAttributeMaxDynamicSharedMemorySize, LDS_BYTES) != hipSuccess) { fprintf(stderr, "kernel_launch: hipFuncSetAttribute failed\n"); grid = -1; return; }
        if (hipOccupancyMaxActiveBlocksPerMultiprocessor(&per_cu, (const void*)fwd_kernel, NWAVES * 64, LDS_BYTES) != hipSuccess || per_cu < 1)
            fprintf(stderr, "kernel_launch: note: occupancy query reports %d workgroups per CU\n", per_cu);
        (void)hipGetLastError();
        grid = cus > 256 ? 256 : cus;
    }
    if (grid < 0) return;
    if (hipMemsetAsync((char*)d_ws + WS_CTL, 0, CTL_ZERO_BYTES, stream) != hipSuccess) { fprintf(stderr, "kernel_launch: memset failed\n"); return; }
    Args a{};
    for (int i = 0; i < 20; ++i) a.in[i] = (const float*)d_in[i];
    a.out = (float*)d_out; a.ws = (unsigned char*)d_ws;
#if MK_SINGLE
    a.ph_lo = 0; a.ph_hi = NPHASE;
    hipLaunchKernelGGL(fwd_kernel, dim3(grid), dim3(NWAVES * 64), LDS_BYTES, stream, a);
#else
    for (int p = 0; p < NPHASE; ++p) { a.ph_lo = p; a.ph_hi = p + 1; hipLaunchKernelGGL(fwd_kernel, dim3(grid), dim3(NWAVES * 64), LDS_BYTES, stream, a); }
#endif
    const hipError_t le = hipPeekAtLastError();
    if (le != hipSuccess) fprintf(stderr, "kernel_launch: launch failed: %s\n", hipGetErrorName(le));
}
```

```cpp
#include <hip/hip_runtime.h>
#include <cstdio>
#include <cstdint>

#ifndef MK_SINGLE
#define MK_SINGLE 1
#endif

#ifndef CTX_GATES
#define CTX_GATES 1
#endif
#ifndef CTX_SPLITK
#define CTX_SPLITK 1
#endif
#ifndef PROBE_DUP
#define PROBE_DUP 0
#endif
#define GAS __attribute__((address_space(1)))
#define LAS __attribute__((address_space(3)))
typedef unsigned short bf16_t;
typedef short bf16x8 __attribute__((ext_vector_type(8)));
typedef float f32x4 __attribute__((ext_vector_type(4)));
typedef float f32x2 __attribute__((ext_vector_type(2)));
typedef float f32x16 __attribute__((ext_vector_type(16)));
typedef unsigned u32x4 __attribute__((ext_vector_type(4)));
typedef unsigned u32x2 __attribute__((ext_vector_type(2)));

constexpr int D = 1024, NBATCH = 4, SEQ = 8192, DEPTH = 4, CTXL = 256;
constexpr int MLAT = NBATCH * SEQ;
constexpr int MCTX = NBATCH * CTXL;
constexpr int MT = MLAT + MCTX;
constexpr int NPAN = MT / 256;
constexpr int NPAN_LAT = MLAT / 256;
constexpr int NIN = 6912, DFF = 2816;
constexpr float NORM_EPS = 1e-6f;
constexpr float LOG2E = 1.4426950408889634f;
constexpr float C2 = 0.125f * LOG2E;
constexpr float NEGBIG = -30000.0f;

constexpr size_t MiB = 1u << 20;
constexpr size_t WS_CTL = 0, CTL_ZERO_BYTES = 1 * MiB;
constexpr size_t WS_MOD = 1 * MiB;
constexpr size_t WS_COS = 2 * MiB, WS_SIN = 3 * MiB;
constexpr size_t WS_CT = 4 * MiB;
constexpr size_t WS_W = 12 * MiB;
constexpr size_t W_LAYER_ELEMS = 18350080;
constexpr size_t WO_W1 = 0, WO_WBR = 7077888, WO_WO = 8650752, WO_W4 = 9699328, WO_W5 = 15466496;
constexpr size_t WS_H = 152 * MiB;
constexpr size_t WS_XC = 218 * MiB;
constexpr size_t WS_Z = 222 * MiB;
constexpr size_t Z33 = 33 * MiB;
constexpr size_t WS_QA = WS_Z, WS_QB = WS_Z + Z33, WS_CGB = WS_Z + 2 * Z33, WS_KA = WS_Z + 3 * Z33, WS_VAT = WS_Z + 4 * Z33, WS_U = WS_Z + 5 * Z33;
constexpr size_t WS_KB = WS_Z + 6 * Z33, WS_VBT = WS_KB + (size_t)MT * 128 * 2;
constexpr size_t WS_MERGED = WS_KA;
constexpr size_t WS_ACT = WS_Z;
constexpr size_t WS_SCR = 437 * MiB;
constexpr size_t WS_GATEC = 501 * MiB;
constexpr size_t WS_END = 507 * MiB;
static_assert(WS_VBT + (size_t)MT * 128 * 2 <= WS_SCR, "ws map");
static_assert(WS_ACT + (size_t)MT * DFF * 2 <= WS_KB, "act overlay");
static_assert(WS_W + 4 * W_LAYER_ELEMS * 2 <= WS_H, "weights");

constexpr int CW_BAR = 4096;

constexpr int RING_OFF = 0, RING_BYTES = 131072;
constexpr int LDSCTL_OFF = RING_BYTES, MISC_OFF = LDSCTL_OFF + 320;
constexpr int LDS_BYTES = 147456;
constexpr int NWAVES = 8;

typedef __bf16 bf16x2_t __attribute__((ext_vector_type(2)));
__device__ __forceinline__ unsigned cvt_pk_bf16(float lo, float hi) { const f32x2 v = {lo, hi}; const bf16x2_t b = __builtin_convertvector(v, bf16x2_t); return __builtin_bit_cast(unsigned, b); }
__device__ __forceinline__ float bf_lo(unsigned w) { return __uint_as_float(w << 16); }
__device__ __forceinline__ float bf_hi(unsigned w) { return __uint_as_float(w & 0xffff0000u); }
__device__ __forceinline__ unsigned short f2bf(float f) { return (unsigned short)(cvt_pk_bf16(f, 0.f) & 0xffffu); }
__device__ __forceinline__ float fast_sigmoid(float x) { return __builtin_amdgcn_rcpf(1.0f + __builtin_amdgcn_exp2f(-x * LOG2E)); }
__device__ __forceinline__ u32x4 pack8(f32x4 a, f32x4 b) { u32x4 w; w.x = cvt_pk_bf16(a[0], a[1]); w.y = cvt_pk_bf16(a[2], a[3]); w.z = cvt_pk_bf16(b[0], b[1]); w.w = cvt_pk_bf16(b[2], b[3]); return w; }
__device__ __forceinline__ void unpack8(u32x4 w, f32x4& a, f32x4& b) { a[0] = bf_lo(w.x); a[1] = bf_hi(w.x); a[2] = bf_lo(w.y); a[3] = bf_hi(w.y); b[0] = bf_lo(w.z); b[1] = bf_hi(w.z); b[2] = bf_lo(w.w); b[3] = bf_hi(w.w); }
__device__ __forceinline__ float wave_sum(float v) {
#pragma unroll
    for (int o = 1; o < 64; o <<= 1) v += __shfl_xor(v, o);
    return v;
}
#define LDS_WAIT() asm volatile("s_waitcnt lgkmcnt(0)" ::: "memory")
__device__ __forceinline__ int opaque_tid() { int t = threadIdx.x; asm volatile("" : "+v"(t)); return t; }
typedef GAS bf16_t* gbf_p; typedef GAS float* gf32_p; typedef const GAS float* gcf32_p; typedef GAS u32x4* gu4_p;
__device__ __forceinline__ void st16(const void* base, unsigned off, u32x4 v) { *(GAS u32x4*)((GAS char*)base + off) = v; }
__device__ __forceinline__ void st16f(const void* base, unsigned off, f32x4 v) { *(GAS f32x4*)((GAS char*)base + off) = v; }
__device__ __forceinline__ void st2(const void* base, unsigned off, unsigned short v) { *(GAS unsigned short*)((GAS char*)base + off) = v; }
__device__ __forceinline__ u32x4 ld16(const void* base, unsigned off) { return *(const GAS u32x4*)((const GAS char*)base + off); }
__device__ __forceinline__ f32x4 ld16f(const void* base, unsigned off) { return *(const GAS f32x4*)((const GAS char*)base + off); }
#define OPAQUE_S(p) asm volatile("" : "+s"(p))

#define XB_TMO      128
#define XB_XCNT(j)  (256  + 64 * (j))
#define XB_XSUB(j)  (1280 + 64 * (j))
#define XB_XGEN(j)  (2304 + 64 * (j))
#define XB_TOP      3328
#define XB_TOPGEN   3392
#define XCD_BAR_WORDS 3456
#define XB_SPIN_CAP (1u << 18)
__device__ __forceinline__ unsigned xb_ld(unsigned* p)              { return __hip_atomic_load(p, __ATOMIC_RELAXED, __HIP_MEMORY_SCOPE_AGENT); }
__device__ __forceinline__ unsigned xb_add(unsigned* p, unsigned v) { return __hip_atomic_fetch_add(p, v, __ATOMIC_RELAXED, __HIP_MEMORY_SCOPE_AGENT); }
__device__ __forceinline__ unsigned xb_xcc_id() { return (unsigned)__builtin_amdgcn_s_getreg((3 << 11) | 20) & 0xFu; }
#define XB_SPIN(cond, bar) do { unsigned _sp = 0; while (cond) { __builtin_amdgcn_s_sleep(1); \
    if ((++_sp & 255u) == 0u) { if (xb_ld(&(bar)[XB_TMO])) break; if (_sp > XB_SPIN_CAP) { atomicAdd(&(bar)[XB_TMO], 1u); break; } } } } while (0)
struct XcdBarrier { unsigned* bar; unsigned x; volatile LAS unsigned* st; };
__device__ __forceinline__ XcdBarrier xcd_barrier_post(unsigned* bar, volatile LAS unsigned* st) {
    XcdBarrier b; b.bar = bar; b.x = xb_xcc_id(); b.st = st;
    if (threadIdx.x == 0) (void)xb_add(&bar[XB_XCNT(b.x)], 1u);
    return b;
}
__device__ __forceinline__ void xcd_barrier_complete(unsigned* bar, unsigned x, unsigned& nloc, unsigned& nx) {
    const unsigned G = gridDim.x * gridDim.y * gridDim.z;
    unsigned sum, cnt, mine, sp = 0u;
    for (;;) {
        sum = 0u; cnt = 0u; mine = 0u;
#pragma unroll
        for (unsigned j = 0; j < 16; ++j) { const unsigned c = xb_ld(&bar[XB_XCNT(j)]); sum += c; cnt += (c > 0u) ? 1u : 0u; mine = (j == x) ? c : mine; }
        if (sum == G) break;
        __builtin_amdgcn_s_sleep(1);
        if ((++sp & 255u) == 0u) { if (xb_ld(&bar[XB_TMO])) break; if (sp > XB_SPIN_CAP) { atomicAdd(&bar[XB_TMO], 1u); break; } }
    }
    nloc = mine > 0u ? mine : 1u; nx = cnt > 0u ? cnt : 1u;
}
__device__ __forceinline__ void xcd_barrier(const XcdBarrier& b) {
    asm volatile("s_waitcnt vmcnt(0)" ::: "memory");
    __syncthreads();
    if (threadIdx.x == 0) {
        unsigned* bar = b.bar;
        __builtin_amdgcn_s_waitcnt(0);
        unsigned nloc = b.st[0], nx = b.st[1];
        if (nloc == 0u) { xcd_barrier_complete(bar, b.x, nloc, nx); b.st[0] = nloc; b.st[1] = nx; }
        const unsigned old = xb_add(&bar[XB_XSUB(b.x)], 1u);
        const unsigned gen = old / nloc;
        if (old + 1u == (gen + 1u) * nloc) {
            __builtin_amdgcn_fence(__ATOMIC_RELEASE, "agent");
            asm volatile("s_waitcnt vmcnt(0)" ::: "memory");
            const unsigned og = xb_add(&bar[XB_TOP], 1u);
            const unsigned tg = og / nx;
            if (og + 1u == (tg + 1u) * nx) xb_add(&bar[XB_TOPGEN], 1u);
            else XB_SPIN(xb_ld(&bar[XB_TOPGEN]) == tg, bar);
            __builtin_amdgcn_fence(__ATOMIC_ACQUIRE, "agent");
            xb_add(&bar[XB_XGEN(b.x)], 1u);
            asm volatile("s_waitcnt vmcnt(0)" ::: "memory");
        } else {
            XB_SPIN(xb_ld(&bar[XB_XGEN(b.x)]) == gen, bar);
            __builtin_amdgcn_fence(__ATOMIC_ACQUIRE, "agent");
            asm volatile("s_waitcnt vmcnt(0)" ::: "memory");
        }
    }
    __syncthreads();
}

namespace pg8 {
constexpr int BM = 256, BK = 64, HALF = 128, HTB = HALF * BK * 2, STAGE_BYTES = 8 * HTB, NXCD = 8, WGM = 8;
__host__ __device__ __forceinline__ int lds_byte(int r, int c) { const int st = (r >> 4) * 2 + (c >> 5), rr = r & 15, cc = c & 31, ob = rr * 64 + cc * 2; return st * 1024 + (ob ^ (((ob >> 9) & 1) << 5)); }
__host__ __device__ __forceinline__ void stage_rc(int b, int& R, int& C) { const int st = b / 1024, sb = b % 1024, swz = sb ^ (((sb >> 9) & 1) << 5); R = (st >> 1) * 16 + swz / 64; C = (st & 1) * 32 + (swz % 64) / 2; }
__host__ __device__ __forceinline__ int perm32(int rho) { const int n = rho >> 4, i = rho & 15; return 8 * (i >> 2) + 4 * n + (i & 3); }

struct GUnit { const char* A; const char* B; unsigned lda2, ldb2; int nt; int pm, pn, mode; };

__device__ __forceinline__ bool tile_order(long L, int nM, int nN, int& pm, int& pn) {
    const int nwg = nM * nN; if (L >= nwg) return false;
    int wgid = (int)L; { const int q = nwg / NXCD, r = nwg % NXCD, xcd = wgid % NXCD, off = wgid / NXCD; wgid = (xcd < r ? xcd * (q + 1) : r * (q + 1) + (xcd - r) * q) + off; }
    const int nig = WGM * nN, gid = wgid / nig, fm = gid * WGM, gsz = (nM - fm) < WGM ? (nM - fm) : WGM;
    pm = fm + ((wgid % nig) % gsz); pn = (wgid % nig) / gsz; return true;
}

template <class Epi, class Sched>
__device__ __forceinline__ void gemm_phase(LAS unsigned char* lds, const Sched& S, const Epi& E) {
    const int tid = opaque_tid(), wid = __builtin_amdgcn_readfirstlane(tid >> 6), lane = tid & 63, wr = wid >> 2, wc = wid & 3, fr = lane & 15, fq = lane >> 4;
    const size_t kstep = (size_t)(BK * 2);
    const unsigned ldsw = (unsigned)wid * 1024u;
    const int aoff = lds_byte(wr * 64 + fr, fq * 8), boff = lds_byte(wc * 32 + fr, fq * 8);
#define PG8_SA(b, h) (((b) * 2 + (h)) * HTB)
#define PG8_SB(b, h) ((4 + (b) * 2 + (h)) * HTB)
#define PG8_STAGE(bufoff, gbase, voff) do { _Pragma("unroll") for (int _i = 0; _i < 2; ++_i) \
        __builtin_amdgcn_global_load_lds((const unsigned*)((const char*)(gbase) + (voff)[_i]), (LAS unsigned*)(lds + (bufoff) + ldsw + _i * 8192), 16, 0, 0); } while (0)
#define PG8_LDA(dst, b, h) do { _Pragma("unroll") for (int m = 0; m < 4; ++m) _Pragma("unroll") for (int k = 0; k < 2; ++k) dst[m][k] = *(const LAS bf16x8*)(lds + PG8_SA(b, h) + aoff + m * 2048 + k * 1024); } while (0)
#define PG8_LDB(dst, b, h) do { _Pragma("unroll") for (int n = 0; n < 2; ++n) _Pragma("unroll") for (int k = 0; k < 2; ++k) dst[n][k] = *(const LAS bf16x8*)(lds + PG8_SB(b, h) + boff + n * 2048 + k * 1024); } while (0)
#define PG8_MMA(ai, bj, At, Bt) do { __builtin_amdgcn_s_setprio(1); _Pragma("unroll") for (int m = 0; m < 4; ++m) _Pragma("unroll") for (int n = 0; n < 2; ++n) _Pragma("unroll") for (int k = 0; k < 2; ++k) \
        acc[ai][bj][m][n] = __builtin_amdgcn_mfma_f32_16x16x32_bf16(Bt[n][k], At[m][k], acc[ai][bj][m][n], 0, 0, 0); __builtin_amdgcn_s_setprio(0); } while (0)
#define PG8_WAIT_V(n) asm volatile("s_waitcnt vmcnt(" #n ")" ::: "memory")
#define PG8_WAIT_L(n) asm volatile("s_waitcnt lgkmcnt(" #n ")" ::: "memory")
#define PG8_BAR __builtin_amdgcn_s_barrier()
#define PG8_SCHED __builtin_amdgcn_sched_barrier(0)
#define PG8_VOFF(u, vA, vB) do { int t_ = tid; asm volatile("" : "+v"(t_)); _Pragma("unroll") for (int _i = 0; _i < 2; ++_i) { int R_, C_; stage_rc(t_ * 16 + _i * 8192, R_, C_); \
        const unsigned Rb_ = (unsigned)(Epi::PERM ? ((R_ & ~31) + perm32(R_ & 31)) : R_); vA[_i] = (unsigned)R_ * (u).lda2 + (unsigned)C_ * 2u; vB[_i] = Rb_ * (u).ldb2 + (unsigned)C_ * 2u; } } while (0)
    GUnit cur, nxt; int ui = 0;
    if (!S.next(0, cur)) return;
    f32x4 acc[2][2][4][2];
#pragma unroll
    for (int a = 0; a < 2; ++a)
#pragma unroll
        for (int b = 0; b < 2; ++b)
#pragma unroll
            for (int m = 0; m < 4; ++m)
#pragma unroll
                for (int n = 0; n < 2; ++n) acc[a][b][m][n] = (f32x4){0.f, 0.f, 0.f, 0.f};
    bf16x8 At[4][2], B0[2][2], B1[2][2];
    unsigned vA[2], vB[2], nvA[2], nvB[2];
    PG8_VOFF(cur, vA, vB);
    const char* cA = cur.A; const char* cB = cur.B;
    size_t hA = (size_t)HALF * cur.lda2, hB = (size_t)HALF * cur.ldb2;
    PG8_STAGE(PG8_SB(0, 0), cB, vB); PG8_STAGE(PG8_SB(0, 1), cB + hB, vB); PG8_STAGE(PG8_SA(0, 0), cA, vA); PG8_STAGE(PG8_SA(0, 1), cA + hA, vA);
    if (wr == 1) PG8_BAR;
    PG8_WAIT_V(2); PG8_BAR;
    PG8_STAGE(PG8_SB(1, 0), cB + kstep, vB); PG8_STAGE(PG8_SA(1, 0), cA + kstep, vA); PG8_STAGE(PG8_SB(1, 1), cB + hB + kstep, vB);
    PG8_WAIT_V(6); PG8_BAR;
    for (;;) {
        const bool has_next = S.next(ui + 1, nxt);
        const char* nA = cA; const char* nB = cB; size_t nhA = hA, nhB = hB;
        nvA[0] = vA[0]; nvA[1] = vA[1]; nvB[0] = vB[0]; nvB[1] = vB[1];
        if (has_next) { nA = nxt.A; nB = nxt.B; nhA = (size_t)HALF * nxt.lda2; nhB = (size_t)HALF * nxt.ldb2; PG8_VOFF(nxt, nvA, nvB); }
        const int nt = cur.nt;
        for (int t = 0; t < nt; t += 2) {
            const bool last = (t == nt - 2);
            const char* a1 = cA + (size_t)(t + 1) * kstep;
            const char* a2 = last ? nA : cA + (size_t)(t + 2) * kstep; const char* b2 = last ? nB : cB + (size_t)(t + 2) * kstep;
            const char* a3 = a2 + kstep; const char* b3 = b2 + kstep;
            unsigned wA[2], wB[2]; wA[0] = last ? nvA[0] : vA[0]; wA[1] = last ? nvA[1] : vA[1]; wB[0] = last ? nvB[0] : vB[0]; wB[1] = last ? nvB[1] : vB[1];
            const size_t hA2 = last ? nhA : hA, hB2 = last ? nhB : hB;
            PG8_LDB(B0, 0, 0); PG8_LDB(B1, 0, 1); PG8_SCHED; PG8_LDA(At, 0, 0); PG8_STAGE(PG8_SA(1, 1), a1 + hA, vA);
            PG8_WAIT_V(8); PG8_WAIT_L(0); PG8_BAR; PG8_MMA(0, 0, At, B0); PG8_MMA(0, 1, At, B1); PG8_BAR; PG8_SCHED;
            PG8_LDA(At, 0, 1); PG8_STAGE(PG8_SB(0, 0), b2, wB); PG8_STAGE(PG8_SB(0, 1), b2 + hB2, wB); PG8_STAGE(PG8_SA(0, 0), a2, wA);
            PG8_WAIT_V(8); PG8_WAIT_L(0); PG8_BAR; PG8_MMA(1, 0, At, B0); PG8_MMA(1, 1, At, B1); PG8_BAR; PG8_SCHED;
            PG8_LDB(B0, 1, 0); PG8_LDB(B1, 1, 1); PG8_SCHED; PG8_LDA(At, 1, 0); PG8_STAGE(PG8_SA(0, 1), a2 + hA2, wA);
            PG8_WAIT_V(8); PG8_WAIT_L(0); PG8_BAR; PG8_MMA(0, 0, At, B0); PG8_MMA(0, 1, At, B1); PG8_BAR; PG8_SCHED;
            PG8_LDA(At, 1, 1); PG8_STAGE(PG8_SB(1, 0), b3, wB); PG8_STAGE(PG8_SB(1, 1), b3 + hB2, wB); PG8_STAGE(PG8_SA(1, 0), a3, wA);
            PG8_WAIT_V(8); PG8_WAIT_L(0); PG8_BAR; PG8_MMA(1, 0, At, B0); PG8_MMA(1, 1, At, B1); PG8_BAR; PG8_SCHED;
        }
        if (wr == 0) PG8_BAR;
        E(acc, cur, wr, wc, fr, fq);
        if (!has_next) break;
#pragma unroll
        for (int a = 0; a < 2; ++a)
#pragma unroll
            for (int b = 0; b < 2; ++b)
#pragma unroll
                for (int m = 0; m < 4; ++m)
#pragma unroll
                    for (int n = 0; n < 2; ++n) acc[a][b][m][n] = (f32x4){0.f, 0.f, 0.f, 0.f};
        cur = nxt; cA = nA; cB = nB; hA = nhA; hB = nhB; vA[0] = nvA[0]; vA[1] = nvA[1]; vB[0] = nvB[0]; vB[1] = nvB[1]; ++ui;
        if (wr == 1) PG8_BAR;
    }
    PG8_WAIT_V(0);
    PG8_BAR;
#undef PG8_SA
#undef PG8_SB
#undef PG8_STAGE
#undef PG8_LDA
#undef PG8_LDB
#undef PG8_MMA
#undef PG8_WAIT_V
#undef PG8_WAIT_L
#undef PG8_BAR
#undef PG8_SCHED
#undef PG8_VOFF
}

struct SimpleSched {
    const char* A; const char* B; unsigned lda2, ldb2; int nt, nM, nN, G, c;
    __device__ __forceinline__ bool next(int i, GUnit& u) const {
        int pm, pn; if (!tile_order((long)i * G + c, nM, nN, pm, pn)) return false;
        u.A = A + (size_t)pm * 256 * lda2; u.B = B + (size_t)pn * 256 * ldb2; u.lda2 = lda2; u.ldb2 = ldb2; u.nt = nt; u.pm = pm; u.pn = pn; u.mode = 0; return true;
    }
};
struct ResSched {
    const char* A; const char* B; unsigned ld2; int nt, nchunk, nctx, G, c;
    __device__ __forceinline__ bool next(int i, GUnit& u) const {
        constexpr int TL = NPAN_LAT * 4;
        const long L = (long)i * G + c; int pm, pn;
        u.lda2 = ld2; u.ldb2 = ld2;
        if (L < TL) { tile_order(L, NPAN_LAT, 4, pm, pn); u.A = A + (size_t)pm * 256 * ld2; u.B = B + (size_t)pn * 256 * ld2; u.nt = nt; u.mode = 0; }
        else if (CTX_SPLITK) { const int x = (int)(L - TL); if (x >= nctx * nchunk) return false; const int tile = x / nchunk, ch = x - tile * nchunk; pm = NPAN_LAT + (tile >> 2); pn = tile & 3;
            u.A = A + (size_t)pm * 256 * ld2 + (size_t)ch * 512; u.B = B + (size_t)pn * 256 * ld2 + (size_t)ch * 512; u.nt = 4; u.mode = 1 + ch; }
        else { const int x = (int)(L - TL); if (x >= nctx) return false; pm = NPAN_LAT + (x >> 2); pn = x & 3; u.A = A + (size_t)pm * 256 * ld2; u.B = B + (size_t)pn * 256 * ld2; u.nt = nt; u.mode = 0; }
        u.pm = pm; u.pn = pn; return true;
    }
};
struct G1Sched {
    const char* H; const char* W1; int nM, G, c, nextra;
    __device__ __forceinline__ bool next(int i, GUnit& u) const {
        const long L = (long)i * G + c; int pm, pn;
        u.lda2 = 2048; u.ldb2 = 2048; u.nt = 16; u.mode = 0;
        if (L >= (long)nM * 15) { const int x = (int)(L - (long)nM * 15); if (x >= nextra) return false;
            pm = NPAN_LAT + x / 12; const int gt = x % 12; u.A = H + (size_t)pm * 256 * 2048; u.B = W1 + (size_t)(3840 + gt * 256) * 2048; u.pm = pm; u.pn = 15 + gt; return true; }
        if (!tile_order(L, nM, 15, pm, pn)) return false;
        const char* hp = H + (size_t)pm * 256 * 2048;
        if (pn < 13) { u.A = hp; u.B = W1 + (size_t)pn * 256 * 2048; } else { u.A = W1 + (size_t)(3328 + (pn - 13) * 256) * 2048; u.B = hp; }
        u.pm = pm; u.pn = pn; return true;
    }
};
struct G2Sched {
    const char* H; const char* W1; const char* OA; const char* WBR; int nM, G, c;
    __device__ __forceinline__ bool next(int i, GUnit& u) const {
        constexpr int TL = NPAN_LAT * 4;
        const int klat = (c < TL) ? (TL - c + G - 1) / G : 0;
        int pm, pn, sub;
        if (!CTX_GATES) { const int tile = i / 6; sub = i - tile * 6; if (!tile_order((long)tile * G + c, nM, 4, pm, pn)) return false; u.mode = sub; }
        else if (i < 6 * klat) { const int tile = i / 6; sub = i - tile * 6; tile_order((long)tile * G + c, NPAN_LAT, 4, pm, pn); u.mode = sub; }
        else { const int i2 = i - 6 * klat, k2 = i2 / 3; const int x = k2 * G + c; if (x >= (nM - NPAN_LAT) * 4) return false;
            pm = NPAN_LAT + (x >> 2); pn = x & 3; sub = 2 * (i2 - 3 * k2) + 1; u.mode = 8 + (sub >> 1); }
        const int br = sub >> 1;
        if ((sub & 1) == 0) { u.A = H + (size_t)pm * 256 * 2048; u.B = W1 + (size_t)(3840 + br * 1024 + pn * 256) * 2048; u.lda2 = 2048; u.ldb2 = 2048; u.nt = 16; }
        else { u.A = OA + (size_t)br * Z33 + (size_t)pm * 256 * 1024; u.B = WBR + (size_t)(br * 1024 + pn * 256) * 1024; u.lda2 = 1024; u.ldb2 = 1024; u.nt = 8; }
        u.pm = pm; u.pn = pn; return true;
    }
};

struct EpiG1 {
    static constexpr bool PERM = true;
    unsigned char* ws; const float* bgate;
    __device__ __forceinline__ void operator()(const f32x4 (&acc)[2][2][4][2], const GUnit& u, int wr, int wc, int fr, int fq) const {
        const int pn = u.pn;
        const unsigned row0 = (unsigned)(u.pm * 256 + wr * 64 + fr);
        const bool latent = u.pm < NPAN_LAT;
        unsigned char* wb = ws; OPAQUE_S(wb);
        if (pn >= 15) {
            const float* bg = bgate; OPAQUE_S(bg);
            const unsigned col0 = (unsigned)((pn - 15) * 256 + wc * 32 + 8 * fq);
            const unsigned lo = ((row0 - MLAT) * 3072u + col0) * 2u;
#pragma unroll
            for (int bj = 0; bj < 2; ++bj) { const f32x4 b0 = ld16f(bg + bj * 128, col0 * 4u), b1 = ld16f(bg + bj * 128 + 4, col0 * 4u);
#pragma unroll
                for (int ai = 0; ai < 2; ++ai)
#pragma unroll
                    for (int m = 0; m < 4; ++m) { f32x4 g0 = acc[ai][bj][m][0] + b0, g1 = acc[ai][bj][m][1] + b1;
#pragma unroll
                        for (int e = 0; e < 4; ++e) { g0[e] = fast_sigmoid(g0[e]); g1[e] = fast_sigmoid(g1[e]); }
                        st16(wb + WS_GATEC + ((ai * 128 + m * 16) * 3072 + bj * 128) * 2, lo, pack8(g0, g1)); } }
        } else if (pn == 2 || pn == 3) {
            const unsigned lo = ((row0 >> 3) * 512u + (row0 & 7) * 8u + (fq & 1) * 64u) * 2u;
#pragma unroll
            for (int bj = 0; bj < 2; ++bj) { const unsigned col = (unsigned)((pn - 2) * 256 + bj * 128 + wc * 32 + 8 * fq); const unsigned ho = ((col >> 6) * (unsigned)(MT * 64) + ((col >> 4) & 3) * 128u) * 2u;
#pragma unroll
                for (int ai = 0; ai < 2; ++ai)
#pragma unroll
                    for (int m = 0; m < 4; ++m) st16(wb + WS_KA + (ai * 128 + m * 16) * 64 * 2, lo + ho, pack8(acc[ai][bj][m][0], acc[ai][bj][m][1])); }
        } else if (pn < 2 || pn == 10 || pn == 11) {
            unsigned char* base = wb + (pn < 2 ? WS_QA : WS_CGB); const float sc = pn < 2 ? C2 : 1.f; const int colt = pn < 2 ? pn * 256 : (pn - 10) * 256;
            const unsigned lo = (row0 * 512u + (unsigned)(colt + wc * 32 + 8 * fq)) * 2u;
#pragma unroll
            for (int ai = 0; ai < 2; ++ai)
#pragma unroll
                for (int m = 0; m < 4; ++m)
#pragma unroll
                    for (int bj = 0; bj < 2; ++bj) st16(base + ((ai * 128 + m * 16) * 512 + bj * 128) * 2, lo, pack8(acc[ai][bj][m][0] * sc, acc[ai][bj][m][1] * sc));
        } else if (pn < 6 || (pn == 12 && wc < 2)) {
            const bool isq = pn < 6;
            unsigned char* base = wb + (isq ? WS_QB : WS_KB); const int head = isq ? (pn - 4) * 4 + wc : wc; const float sc = isq ? C2 : 1.f;
            const unsigned lo = isq ? (row0 * 512u + (unsigned)(head * 64 + 8 * fq)) * 2u
                                    : ((unsigned)head * (unsigned)(MT * 64) + (row0 >> 3) * 512u + (row0 & 7) * 8u + (fq >> 1) * 128u + (fq & 1) * 64u) * 2u;
            const unsigned rstride = isq ? 1024u : 128u, x2off = isq ? 64u : 512u;
            const unsigned t0 = (unsigned)((((u.pm & 31) * 256 + wr * 64 + fr) * 32 + 8 * fq) * 4);
#pragma unroll
            for (int ai = 0; ai < 2; ++ai)
#pragma unroll
                for (int m = 0; m < 4; ++m) {
                    f32x4 x1a = acc[ai][0][m][0], x1b = acc[ai][0][m][1], x2a = acc[ai][1][m][0], x2b = acc[ai][1][m][1];
                    f32x4 o1a = x1a, o1b = x1b, o2a = x2a, o2b = x2b;
                    if (latent) { const unsigned tc = (ai * 128 + m * 16) * 32 * 4;
                        const f32x4 ca = ld16f(wb + WS_COS + tc, t0), cb = ld16f(wb + WS_COS + tc + 16, t0), sa = ld16f(wb + WS_SIN + tc, t0), sb = ld16f(wb + WS_SIN + tc + 16, t0);
                        o1a = x1a * ca - x2a * sa; o1b = x1b * cb - x2b * sb; o2a = x1a * sa + x2a * ca; o2b = x1b * sb + x2b * cb; }
                    unsigned char* rb = base + (size_t)((ai * 128 + m * 16) * rstride);
                    st16(rb, lo, pack8(o1a * sc, o1b * sc)); st16(rb + x2off, lo, pack8(o2a * sc, o2b * sc)); asm volatile("" ::: "memory"); }
        } else if (pn < 10) {
            const unsigned lo = (row0 * 512u + (unsigned)((pn - 6) * 128 + wc * 32 + 8 * fq)) * 2u;
#pragma unroll
            for (int ai = 0; ai < 2; ++ai)
#pragma unroll
                for (int m = 0; m < 4; ++m) st16(wb + WS_U + (ai * 128 + m * 16) * 512 * 2, lo, pack8(acc[ai][0][m][0] * acc[ai][1][m][0], acc[ai][0][m][1] * acc[ai][1][m][1]));
        } else if (pn == 12) {
            const unsigned lo = ((row0 >> 3) * 512u + (unsigned)(((wc - 2) * 32 + 8 * fq) * 8) + (row0 & 7)) * 2u;
#pragma unroll
            for (int ai = 0; ai < 2; ++ai)
#pragma unroll
                for (int m = 0; m < 4; ++m)
#pragma unroll
                    for (int bj = 0; bj < 2; ++bj)
#pragma unroll
                        for (int n = 0; n < 2; ++n)
#pragma unroll
                            for (int e = 0; e < 4; ++e) st2(wb + WS_VBT + (size_t)bj * MT * 64 * 2 + ((4 * n + e) * 8 + (ai * 128 + m * 16) * 64) * 2, lo, f2bf(acc[ai][bj][m][n][e]));
        } else {
            const unsigned f0 = (unsigned)((pn - 13) * 256 + wr * 64 + fr);
            const unsigned lo = ((f0 >> 6) * (unsigned)(MT * 64) + (f0 & 63) * 8u + (unsigned)(u.pm * 32 + wc * 4 + fq) * 512u) * 2u;
#pragma unroll
            for (int ai = 0; ai < 2; ++ai)
#pragma unroll
                for (int m = 0; m < 4; ++m)
#pragma unroll
                    for (int bj = 0; bj < 2; ++bj) st16(wb + WS_VAT + (size_t)(ai * 2) * MT * 64 * 2 + (m * 128 + bj * 16 * 512) * 2, lo, pack8(acc[ai][bj][m][0], acc[ai][bj][m][1]));
        }
    }
};
struct EpiG2 {
    static constexpr bool PERM = true;
    unsigned char* ws; unsigned char* scr; const float* bgate;
    __device__ __forceinline__ void operator()(const f32x4 (&acc)[2][2][4][2], const GUnit& u, int wr, int wc, int fr, int fq) const {
        const bool cx = u.mode >= 8;
        const int sub = cx ? 2 * (u.mode - 8) + 1 : u.mode, br = sub >> 1;
        const unsigned tid16 = (unsigned)(((wr * 4 + wc) * 64 + fq * 16 + fr) * 16);
        unsigned char* wb = ws; unsigned char* sb = scr; const float* bg = bgate; OPAQUE_S(wb); OPAQUE_S(sb); OPAQUE_S(bg);
        if ((sub & 1) == 0) {
            const unsigned bo = (unsigned)((br * 1024 + u.pn * 256 + wc * 32 + 8 * fq) * 4);
            f32x4 bv[2][2];
#pragma unroll
            for (int bj = 0; bj < 2; ++bj)
#pragma unroll
                for (int n = 0; n < 2; ++n) bv[bj][n] = ld16f(bg + bj * 128 + 4 * n, bo);
#pragma unroll
            for (int ai = 0; ai < 2; ++ai)
#pragma unroll
                for (int bj = 0; bj < 2; ++bj)
#pragma unroll
                    for (int m = 0; m < 4; ++m) { f32x4 g0 = acc[ai][bj][m][0] + bv[bj][0], g1 = acc[ai][bj][m][1] + bv[bj][1];
#pragma unroll
                        for (int e = 0; e < 4; ++e) { g0[e] = fast_sigmoid(g0[e]); g1[e] = fast_sigmoid(g1[e]); }
                        st16(sb + ((ai * 2 + bj) * 4 + m) * 8192, tid16, pack8(g0, g1)); }
        } else {
            const unsigned rowl = (unsigned)(u.pm * 256 + wr * 64 + fr), coll = (unsigned)(u.pn * 256 + wc * 32 + 8 * fq);
            const unsigned mo = (rowl * 1024u + coll) * 2u;
            const unsigned go = cx ? ((rowl - MLAT) * 3072u + (unsigned)(br * 1024) + coll) * 2u : 0u;
            if (!cx) { if (br == 0) yepi<false, 0>(acc, wb, sb, tid16, go, mo); else if (br == 1) yepi<false, 1>(acc, wb, sb, tid16, go, mo); else yepi<false, 2>(acc, wb, sb, tid16, go, mo); }
            else     { if (br == 0) yepi<true, 0>(acc, wb, sb, tid16, go, mo);  else if (br == 1) yepi<true, 1>(acc, wb, sb, tid16, go, mo);  else yepi<true, 2>(acc, wb, sb, tid16, go, mo); }
        }
    }
    template <bool CX, int BR>
    static __device__ __forceinline__ void yepi(const f32x4 (&acc)[2][2][4][2], unsigned char* wb, unsigned char* sb, unsigned tid16, unsigned go, unsigned mo) {
#pragma unroll
        for (int ai = 0; ai < 2; ++ai) {
            u32x4 gq[2][4], tq[2][4];
#pragma unroll
            for (int bj = 0; bj < 2; ++bj)
#pragma unroll
                for (int m = 0; m < 4; ++m) { const unsigned k16 = ((ai * 2 + bj) * 4 + m) * 8192;
                    gq[bj][m] = CX ? ld16(wb + WS_GATEC + ((ai * 128 + m * 16) * 3072 + bj * 128) * 2, go) : ld16(sb + k16, tid16);
                    if (BR > 0) tq[bj][m] = ld16(sb + 131072 + k16, tid16); }
#pragma unroll
            for (int bj = 0; bj < 2; ++bj)
#pragma unroll
                for (int m = 0; m < 4; ++m) { const unsigned k16 = ((ai * 2 + bj) * 4 + m) * 8192;
                    f32x4 g0, g1; unpack8(gq[bj][m], g0, g1);
                    f32x4 v0 = g0 * acc[ai][bj][m][0], v1 = g1 * acc[ai][bj][m][1];
                    if (BR > 0) { f32x4 t0, t1; unpack8(tq[bj][m], t0, t1); v0 += t0; v1 += t1; }
                    const u32x4 w = pack8(v0, v1);
                    if (BR < 2) st16(sb + 131072 + k16, tid16, w);
                    else st16(wb + WS_MERGED + ((ai * 128 + m * 16) * 1024 + bj * 128) * 2, mo, w); }
            asm volatile("" ::: "memory");
        }
    }
};
struct EpiRes {
    static constexpr bool PERM = false;
    const float* base_lat; float* out_lat; float* xc; float* part; const float* mod; int goff;
    __device__ __forceinline__ void operator()(const f32x4 (&acc)[2][2][4][2], const GUnit& u, int wr, int wc, int fr, int fq) const {
        const int mode = __builtin_amdgcn_readfirstlane(u.mode), upm = __builtin_amdgcn_readfirstlane(u.pm);
        const bool latent = upm < NPAN_LAT;
        const int prow = latent ? upm : upm - NPAN_LAT;
        const float* base = latent ? base_lat : xc; float* out = latent ? out_lat : xc;
        if (mode != 0) out = (float*)((char*)part + (unsigned)(mode - 1) * (unsigned)(MCTX * D * 4));
        const float* gv = mod + (latent ? (upm >> 5) : 4) * 6144 + goff;
        OPAQUE_S(base); OPAQUE_S(out); OPAQUE_S(gv);
        const unsigned col0 = (unsigned)(u.pn * 256 + wc * 32 + 4 * fq);
        const unsigned lo = ((unsigned)(prow * 256 + wr * 64 + fr) * 1024u + col0) * 4u;
        f32x4 g[2][2];
#pragma unroll
        for (int bj = 0; bj < 2; ++bj)
#pragma unroll
            for (int n = 0; n < 2; ++n) g[bj][n] = ld16f(gv + bj * 128 + n * 16, col0 * 4u);
#pragma unroll
        for (int ai = 0; ai < 2; ++ai) {
            f32x4 bq[4][2][2];
            if (mode == 0) {
#pragma unroll
                for (int m = 0; m < 4; ++m)
#pragma unroll
                    for (int bj = 0; bj < 2; ++bj)
#pragma unroll
                        for (int n = 0; n < 2; ++n) bq[m][bj][n] = ld16f(base + (ai * 128 + m * 16) * 1024 + bj * 128 + n * 16, lo);
            }
#pragma unroll
            for (int m = 0; m < 4; ++m)
#pragma unroll
                for (int bj = 0; bj < 2; ++bj)
#pragma unroll
                    for (int n = 0; n < 2; ++n) { const unsigned oc = (ai * 128 + m * 16) * 1024 + bj * 128 + n * 16;
                        if (mode == 0) st16f(out + oc, lo, bq[m][bj][n] + g[bj][n] * acc[ai][bj][m][n]);
                        else st16f(out + oc, lo, g[bj][n] * acc[ai][bj][m][n]); }
            asm volatile("" ::: "memory"); }
    }
};
struct EpiSwiglu {
    static constexpr bool PERM = true;
    bf16_t* ACT;
    __device__ __forceinline__ void operator()(const f32x4 (&acc)[2][2][4][2], const GUnit& u, int wr, int wc, int fr, int fq) const {
        bf16_t* actb = ACT; OPAQUE_S(actb);
        const unsigned lo = ((unsigned)(u.pm * 256 + wr * 64 + fr) * (unsigned)DFF + (unsigned)(u.pn * 128 + wc * 32 + 8 * fq)) * 2u;
#pragma unroll
        for (int ai = 0; ai < 2; ++ai)
#pragma unroll
            for (int m = 0; m < 4; ++m) { f32x4 a0 = acc[ai][0][m][0], a1 = acc[ai][0][m][1];
#pragma unroll
                for (int e = 0; e < 4; ++e) { a0[e] = a0[e] * fast_sigmoid(a0[e]); a1[e] = a1[e] * fast_sigmoid(a1[e]); }
                st16(actb + (ai * 128 + m * 16) * DFF, lo, pack8(a0 * acc[ai][1][m][0], a1 * acc[ai][1][m][1])); }
    }
};
}

__device__ __forceinline__ int pi32(int m) { return (m & ~12) | ((m & 4) << 1) | ((m & 8) >> 1); }
struct KVF { bf16x8 k[4]; bf16x8 v[4]; };
__device__ __forceinline__ void kv_load(KVF& f, const bf16_t* Kt, const bf16_t* Vt, size_t key0, int koffl, int voffl) {
    const bf16_t* kp = Kt + (key0 >> 3) * 512 + koffl;
#pragma unroll
    for (int d0 = 0; d0 < 4; ++d0) f.k[d0] = *(const bf16x8*)(kp + 128 * d0);
    const bf16_t* vp = Vt + (key0 >> 3) * 512 + voffl;
    f.v[0] = *(const bf16x8*)(vp); f.v[1] = *(const bf16x8*)(vp + 1024); f.v[2] = *(const bf16x8*)(vp + 256); f.v[3] = *(const bf16x8*)(vp + 1280);
}
constexpr float RESC_THR = 8.0f;
__device__ __forceinline__ void attn_compute(const KVF& f, const bf16x8 (&qf)[4], f32x16 s, int maskmode, int r32, int hi, f32x16& o0, f32x16& o1, float& m, float& l) {
#pragma unroll
    for (int d0 = 0; d0 < 4; ++d0) s = __builtin_amdgcn_mfma_f32_32x32x16_bf16(f.k[d0], qf[d0], s, 0, 0, 0);
    if (maskmode != 0) {
#pragma unroll
        for (int r = 0; r < 16; ++r) { const int koff = 16 * (r >> 3) + 8 * hi + (r & 7); const bool ok = (maskmode == 1) ? (koff >= r32) : (koff <= r32); s[r] = ok ? s[r] : NEGBIG; }
    }
    float bm = fmaxf(fmaxf(s[0], s[1]), s[2]);
#pragma unroll
    for (int r = 3; r < 15; r += 2) bm = fmaxf(fmaxf(bm, s[r]), s[r + 1]);
    bm = fmaxf(bm, s[15]);
    bm = fmaxf(bm, __shfl_xor(bm, 32));
    if (__any(bm > m + RESC_THR)) {
        const float mn = fmaxf(m, bm);
        const float alpha = __builtin_amdgcn_exp2f(m - mn);
        m = mn; l *= alpha;
#pragma unroll
        for (int r = 0; r < 16; ++r) { o0[r] *= alpha; o1[r] *= alpha; }
    }
    float ps = 0.f;
#pragma unroll
    for (int r = 0; r < 16; ++r) { s[r] = __builtin_amdgcn_exp2f(s[r] - m); ps += s[r]; }
    l += ps;
    u32x4 w0, w1;
    w0.x = cvt_pk_bf16(s[0], s[1]); w0.y = cvt_pk_bf16(s[2], s[3]); w0.z = cvt_pk_bf16(s[4], s[5]); w0.w = cvt_pk_bf16(s[6], s[7]);
    w1.x = cvt_pk_bf16(s[8], s[9]); w1.y = cvt_pk_bf16(s[10], s[11]); w1.z = cvt_pk_bf16(s[12], s[13]); w1.w = cvt_pk_bf16(s[14], s[15]);
    const bf16x8 p0 = __builtin_bit_cast(bf16x8, w0), p1 = __builtin_bit_cast(bf16x8, w1);
    o0 = __builtin_amdgcn_mfma_f32_32x32x16_bf16(f.v[0], p0, o0, 0, 0, 0);
    o0 = __builtin_amdgcn_mfma_f32_32x32x16_bf16(f.v[1], p1, o0, 0, 0, 0);
    o1 = __builtin_amdgcn_mfma_f32_32x32x16_bf16(f.v[2], p0, o1, 0, 0, 0);
    o1 = __builtin_amdgcn_mfma_f32_32x32x16_bf16(f.v[3], p1, o1, 0, 0, 0);
}
__device__ __forceinline__ void attn_finish(bf16_t* orow, const f32x16& o0, const f32x16& o1, float l, int hi) {
    const float lt = l + __shfl_xor(l, 32);
    const float inv = 1.0f / lt;
#pragma unroll
    for (int g = 0; g < 4; ++g) {
        u32x2 a, b;
        a.x = cvt_pk_bf16(o0[4 * g] * inv, o0[4 * g + 1] * inv); a.y = cvt_pk_bf16(o0[4 * g + 2] * inv, o0[4 * g + 3] * inv);
        b.x = cvt_pk_bf16(o1[4 * g] * inv, o1[4 * g + 1] * inv); b.y = cvt_pk_bf16(o1[4 * g + 2] * inv, o1[4 * g + 3] * inv);
        *(u32x2*)(orow + 8 * g + 4 * hi) = a; *(u32x2*)(orow + 32 + 8 * g + 4 * hi) = b;
    }
}
__device__ __forceinline__ f32x16 zero16() { f32x16 z;
#pragma unroll
    for (int r = 0; r < 16; ++r) z[r] = 0.f;
    return z; }
__device__ __forceinline__ f32x16 load16(const float* p) { const f32x4 a = *(const f32x4*)p, b = *(const f32x4*)(p + 256), c = *(const f32x4*)(p + 512), d = *(const f32x4*)(p + 768);
    f32x16 z; z[0] = a[0]; z[1] = a[1]; z[2] = a[2]; z[3] = a[3]; z[4] = b[0]; z[5] = b[1]; z[6] = b[2]; z[7] = b[3]; z[8] = c[0]; z[9] = c[1]; z[10] = c[2]; z[11] = c[3]; z[12] = d[0]; z[13] = d[1]; z[14] = d[2]; z[15] = d[3]; return z; }

__device__ __forceinline__ void attn_ctx_blocks(const bf16_t* Kt, const bf16_t* Vt, size_t key0, const bf16x8 (&qf)[4], int koffl, int voffl, int r32, int hi, f32x16& o0, f32x16& o1, float& m, float& l) {
    KVF fa, fb;
    kv_load(fa, Kt, Vt, key0, koffl, voffl);
#pragma unroll 1
    for (int kb = 0; kb < 8; kb += 2) {
        kv_load(fb, Kt, Vt, key0 + (kb + 1) * 32, koffl, voffl);
        attn_compute(fa, qf, zero16(), 0, r32, hi, o0, o1, m, l);
        if (kb + 2 < 8) kv_load(fa, Kt, Vt, key0 + (kb + 2) * 32, koffl, voffl);
        attn_compute(fb, qf, zero16(), 0, r32, hi, o0, o1, m, l);
    }
}
struct AttnPtrs { bf16_t* QA; const bf16_t* KA; const bf16_t* VAT; bf16_t* QB; const bf16_t* KB; const bf16_t* VBT; const float* CT; const float* sink; };
#define ATTN_LANE() const int r32 = lane & 31, hi = lane >> 5; const int kp_ = pi32(r32); const int koffl = (kp_ >> 3) * 512 + hi * 64 + (kp_ & 7) * 8, voffl = hi * 512 + r32 * 8

__device__ __forceinline__ void na_task(const AttnPtrs& P, int l, int b, int h, int r, int half, int lane, bf16_t* oalt) {
    ATTN_LANE();
    const size_t qrow = (size_t)b * SEQ + r * 64 + half * 32 + r32;
    bf16_t* qp = P.QA + qrow * 512 + h * 64;
    bf16x8 qf[4];
#pragma unroll
    for (int d0 = 0; d0 < 4; ++d0) qf[d0] = *(const bf16x8*)(qp + d0 * 16 + hi * 8);
    f32x16 o0 = zero16(), o1 = zero16(); float m = -1e30f, lsum = 0.f;
    const bf16_t* Kh = P.KA + (size_t)h * MT * 64; const bf16_t* Vh = P.VAT + (size_t)h * MT * 64;
    attn_ctx_blocks(Kh, Vh, (size_t)(MLAT + b * CTXL), qf, koffl, voffl, r32, hi, o0, o1, m, lsum);
    const int r0 = min(max(r - 4, 0), 120);
    const float* ctb = P.CT + ((size_t)((l * 8 + h) * 15 + (r0 - r + 7)) * 4 + half * 2) * 1024 + lane * 4;
    const size_t key00 = (size_t)b * SEQ + r0 * 64;
    KVF fa, fb; f32x16 ca, cb;
    kv_load(fa, Kh, Vh, key00, koffl, voffl); ca = load16(ctb);
#pragma unroll 1
    for (int j = 0; j < 16; j += 2) {
        kv_load(fb, Kh, Vh, key00 + (j + 1) * 32, koffl, voffl); cb = load16(ctb + (size_t)((j >> 1) * 4 + 1) * 1024);
        attn_compute(fa, qf, ca, 0, r32, hi, o0, o1, m, lsum);
        if (j + 2 < 16) { kv_load(fa, Kh, Vh, key00 + (j + 2) * 32, koffl, voffl); ca = load16(ctb + (size_t)(((j + 2) >> 1) * 4) * 1024); }
        attn_compute(fb, qf, cb, 0, r32, hi, o0, o1, m, lsum);
    }
    attn_finish(oalt ? oalt + qrow * 512 + h * 64 : qp, o0, o1, lsum, hi);
}
__device__ __forceinline__ void swa_task(const AttnPtrs& P, int l, int b, int h, int qblk, int lane, bf16_t* oalt) {
    ATTN_LANE();
    const int g = h >> 2;
    const size_t qrow = (size_t)b * SEQ + qblk * 32 + r32;
    bf16_t* qp = P.QB + qrow * 512 + h * 64;
    bf16x8 qf[4];
#pragma unroll
    for (int d0 = 0; d0 < 4; ++d0) qf[d0] = *(const bf16x8*)(qp + d0 * 16 + hi * 8);
    f32x16 o0 = zero16(), o1 = zero16(); float m = P.sink[l * 8 + h] * LOG2E, lsum = (hi == 0) ? 1.f : 0.f;
    const bf16_t* Kh = P.KB + (size_t)g * MT * 64; const bf16_t* Vh = P.VBT + (size_t)g * MT * 64;
    attn_ctx_blocks(Kh, Vh, (size_t)(MLAT + b * CTXL), qf, koffl, voffl, r32, hi, o0, o1, m, lsum);
    const int jlo = (qblk < 4) ? (4 - qblk) : 0, jhi = (qblk > 251) ? (255 - qblk + 4) : 8;
    const int kb0 = b * SEQ + (qblk - 4) * 32;
    KVF fa, fb;
    kv_load(fa, Kh, Vh, (size_t)(kb0 + jlo * 32), koffl, voffl);
#pragma unroll 1
    for (int j = jlo; j <= jhi; j += 2) {
        if (j + 1 <= jhi) kv_load(fb, Kh, Vh, (size_t)(kb0 + (j + 1) * 32), koffl, voffl);
        attn_compute(fa, qf, zero16(), (j == 0) ? 1 : ((j == 8) ? 2 : 0), r32, hi, o0, o1, m, lsum);
        if (j + 2 <= jhi) kv_load(fa, Kh, Vh, (size_t)(kb0 + (j + 2) * 32), koffl, voffl);
        if (j + 1 <= jhi) attn_compute(fb, qf, zero16(), (j + 1 == 8) ? 2 : 0, r32, hi, o0, o1, m, lsum);
    }
    attn_finish(oalt ? oalt + qrow * 512 + h * 64 : qp, o0, o1, lsum, hi);
}
__device__ __forceinline__ void ctx_task(const AttnPtrs& P, int l, int typ, int b, int h, int qblk, int lane, bf16_t* oalt) {
    ATTN_LANE();
    const size_t qrow = (size_t)MLAT + b * CTXL + qblk * 32 + r32;
    bf16_t* qp = (typ == 0 ? P.QA : P.QB) + qrow * 512 + h * 64;
    bf16x8 qf[4];
#pragma unroll
    for (int d0 = 0; d0 < 4; ++d0) qf[d0] = *(const bf16x8*)(qp + d0 * 16 + hi * 8);
    f32x16 o0 = zero16(), o1 = zero16(); float m, lsum;
    if (typ == 0) { m = -1e30f; lsum = 0.f;
        attn_ctx_blocks(P.KA + (size_t)h * MT * 64, P.VAT + (size_t)h * MT * 64, (size_t)(MLAT + b * CTXL), qf, koffl, voffl, r32, hi, o0, o1, m, lsum); }
    else { const int g = h >> 2; m = P.sink[l * 8 + h] * LOG2E; lsum = (hi == 0) ? 1.f : 0.f;
        attn_ctx_blocks(P.KB + (size_t)g * MT * 64, P.VBT + (size_t)g * MT * 64, (size_t)(MLAT + b * CTXL), qf, koffl, voffl, r32, hi, o0, o1, m, lsum); }
    attn_finish(oalt ? oalt + qrow * 512 + h * 64 : qp, o0, o1, lsum, hi);
}

__device__ __forceinline__ void transpose_item(const float* W, int K, int N, bf16_t* WT, int ncol0, int nrow0, int k0, LAS float* scr, int lane) {
#pragma unroll 8
    for (int i = 0; i < 32; ++i) { const int kk = 2 * i + (lane >> 5); scr[kk * 33 + (lane & 31)] = W[(size_t)(k0 + kk) * N + ncol0 + (lane & 31)]; }
    LDS_WAIT(); asm volatile("" ::: "memory");
    const int c = lane & 7;
#pragma unroll
    for (int j = 0; j < 4; ++j) { const int n = (lane >> 3) + 8 * j; const LAS float* s = scr + (8 * c) * 33 + n;
        u32x4 o; o.x = cvt_pk_bf16(s[0 * 33], s[1 * 33]); o.y = cvt_pk_bf16(s[2 * 33], s[3 * 33]); o.z = cvt_pk_bf16(s[4 * 33], s[5 * 33]); o.w = cvt_pk_bf16(s[6 * 33], s[7 * 33]);
        *(u32x4*)(WT + (size_t)(nrow0 + n) * K + k0 + 8 * c) = o; }
    LDS_WAIT(); asm volatile("" ::: "memory");
}
__device__ __forceinline__ int srcmap1(int n) {
    if (n < 1024) return n;
    if (n < 1536) { const int t = (n - 1024) >> 8, j = (n - 1024) & 255, half = j >> 7, jj = j & 127; return 1536 + (t * 4 + (jj >> 5)) * 64 + half * 32 + (jj & 31); }
    if (n < 2560) { const int t = (n - 1536) >> 8, j = (n - 1536) & 255, half = j >> 7, jj = j & 127; return (half ? 3328 : 2304) + t * 128 + jj; }
    if (n < 3072) return 2816 + (n - 2560);
    if (n < 3328) { const int j = n - 3072, half = j >> 7, jj = j & 127; if (jj < 64) return 2048 + (jj >> 5) * 64 + half * 32 + (jj & 31); return 2176 + half * 64 + (jj - 64); }
    if (n < 3840) return 1024 + (n - 3328);
    return n;
}
__device__ __forceinline__ int srcmap4(int n) { const int t = n >> 8, j = n & 255; return (j >> 7) * DFF + t * 128 + (j & 127); }

struct Args { const float* in[20]; float* out; unsigned char* ws; int ph_lo, ph_hi; };
constexpr int NPHASE = 2 + 8 * DEPTH;

__global__ void __launch_bounds__(NWAVES * 64, 2) fwd_kernel(Args args) {
    extern __shared__ __attribute__((aligned(16))) unsigned char lds_raw[];
    LAS unsigned char* lds = (LAS unsigned char*)lds_raw;
    const int G = gridDim.x, bx = blockIdx.x;
    const int vcu = (G % 8 == 0) ? (bx % 8) * (G / 8) + bx / 8 : bx;
    const int NGW = G * NWAVES;
#define PHASE_IDS() const int tid = opaque_tid(); const int lane = tid & 63, wave = __builtin_amdgcn_readfirstlane(tid >> 6); const int gw = vcu * NWAVES + wave; (void)lane; (void)gw
    unsigned char* ws = args.ws;
    unsigned* ctl = (unsigned*)(ws + WS_CTL);
    const float* x_in = args.in[0]; const float* c_in = args.in[1]; const float* ctx_in = args.in[2]; const float* cctx_in = args.in[3];
    const float* w_ada = args.in[4]; const float* b_ada = args.in[5]; const float* norm1_g = args.in[6]; const float* norm2_g = args.in[7];
    const float* w_in = args.in[8]; const float* b_gate = args.in[9]; const float* na_rpb = args.in[10]; const float* sw_sink = args.in[11];
    const float* conv_w = args.in[12]; const float* w_br_a = args.in[13]; const float* w_br_b = args.in[14]; const float* w_br_c = args.in[15];
    const float* w_o = args.in[16]; const float* w_up = args.in[17]; const float* w_down = args.in[18]; const float* final_g = args.in[19];
    float* out = args.out;
    float* MOD = (float*)(ws + WS_MOD); float* COS = (float*)(ws + WS_COS); float* SIN = (float*)(ws + WS_SIN); float* CT = (float*)(ws + WS_CT);
    bf16_t* WB = (bf16_t*)(ws + WS_W); bf16_t* H = (bf16_t*)(ws + WS_H); float* XC = (float*)(ws + WS_XC);
    bf16_t* QA = (bf16_t*)(ws + WS_QA); bf16_t* KA = (bf16_t*)(ws + WS_KA); bf16_t* VAT = (bf16_t*)(ws + WS_VAT); bf16_t* QB = (bf16_t*)(ws + WS_QB);
    bf16_t* U = (bf16_t*)(ws + WS_U); bf16_t* CGB = (bf16_t*)(ws + WS_CGB); bf16_t* KB = (bf16_t*)(ws + WS_KB); bf16_t* VBT = (bf16_t*)(ws + WS_VBT);
    bf16_t* MERGED = (bf16_t*)(ws + WS_MERGED); bf16_t* ACT = (bf16_t*)(ws + WS_ACT); bf16_t* GATEC = (bf16_t*)(ws + WS_GATEC);

    for (int u = threadIdx.x; u < (LDS_BYTES - LDSCTL_OFF) / 4; u += NWAVES * 64) ((LAS unsigned*)(lds + LDSCTL_OFF))[u] = 0u;
    __syncthreads();
    volatile LAS unsigned* MISC = (volatile LAS unsigned*)(lds + MISC_OFF);
    XcdBarrier bar; bar.bar = ctl + CW_BAR; bar.x = 0; bar.st = nullptr;
#if MK_SINGLE
    bar = xcd_barrier_post(ctl + CW_BAR, MISC + 8);
#endif
    const int lo = args.ph_lo, hi_ph = args.ph_hi;
#define IN(k) (lo <= (k) && (k) < hi_ph)
#define SEAM(k) do { if (IN(k) && IN((k) + 1)) xcd_barrier(bar); } while (0)

    if (IN(0)) {
        PHASE_IDS();
        LAS float* scr = (LAS float*)(lds + RING_OFF + wave * 16384);
        constexpr int I_W1 = (NIN / 32) * (D / 64), I_BR = (D / 32) * (512 / 64), I_WO = (D / 32) * (D / 64), I_W4 = (2 * DFF / 32) * (D / 64), I_W5 = (D / 32) * (DFF / 64);
        constexpr int I_LAYER = I_W1 + 3 * I_BR + I_WO + I_W4 + I_W5;
        for (int it = gw; it < DEPTH * I_LAYER; it += NGW) {
            const int l = it / I_LAYER; int r = it - l * I_LAYER;
            bf16_t* wl = WB + (size_t)l * W_LAYER_ELEMS;
            if (r < I_W1) { const int kb = r / (NIN / 32), nb = r % (NIN / 32); transpose_item(w_in + (size_t)l * D * NIN, D, NIN, wl + WO_W1, srcmap1(nb * 32), nb * 32, kb * 64, scr, lane); continue; } r -= I_W1;
            if (r < 3 * I_BR) { const int br = r / I_BR, rr = r % I_BR, kb = rr / (D / 32), nb = rr % (D / 32); const float* src = (br == 0 ? w_br_a : (br == 1 ? w_br_b : w_br_c)) + (size_t)l * 512 * D;
                transpose_item(src, 512, D, wl + WO_WBR + (size_t)br * D * 512, nb * 32, nb * 32, kb * 64, scr, lane); continue; } r -= 3 * I_BR;
            if (r < I_WO) { const int kb = r / (D / 32), nb = r % (D / 32); transpose_item(w_o + (size_t)l * D * D, D, D, wl + WO_WO, nb * 32, nb * 32, kb * 64, scr, lane); continue; } r -= I_WO;
            if (r < I_W4) { const int kb = r / (2 * DFF / 32), nb = r % (2 * DFF / 32); transpose_item(w_up + (size_t)l * D * 2 * DFF, D, 2 * DFF, wl + WO_W4, srcmap4(nb * 32), nb * 32, kb * 64, scr, lane); continue; } r -= I_W4;
            { const int kb = r / (D / 32), nb = r % (D / 32); transpose_item(w_down + (size_t)l * DFF * D, DFF, D, wl + WO_W5, nb * 32, nb * 32, kb * 64, scr, lane); }
        }
        __syncthreads();
        {
            LAS float* sl = (LAS float*)(lds + RING_OFF);
            LAS float* red = (LAS float*)(lds + RING_OFF + 32768);
            for (int i = tid; i < 5 * D; i += NWAVES * 64) { const int bi = i >> 10, k = i & 1023; const float v = (bi < 4) ? c_in[bi * D + k] : cctx_in[k]; sl[i] = v / (1.0f + __expf(-v)); }
            __syncthreads();
            for (int it = bx; it < DEPTH * 96; it += G) {
                const int l = it / 96, n = (it % 96) * 64 + lane;
                const float* wp = w_ada + ((size_t)l * D + wave * 128) * 6144 + n;
                float a0 = 0.f, a1 = 0.f, a2 = 0.f, a3 = 0.f, a4 = 0.f;
#pragma unroll 8
                for (int k = 0; k < 128; ++k) { const float w = wp[(size_t)k * 6144]; const int kk = wave * 128 + k;
                    a0 += sl[kk] * w; a1 += sl[1024 + kk] * w; a2 += sl[2048 + kk] * w; a3 += sl[3072 + kk] * w; a4 += sl[4096 + kk] * w; }
                red[(wave * 5 + 0) * 64 + lane] = a0; red[(wave * 5 + 1) * 64 + lane] = a1; red[(wave * 5 + 2) * 64 + lane] = a2; red[(wave * 5 + 3) * 64 + lane] = a3; red[(wave * 5 + 4) * 64 + lane] = a4;
                __syncthreads();
                if (tid < 320) { const int bi = tid >> 6, ln = tid & 63; float s = b_ada[l * 6144 + (it % 96) * 64 + ln];
#pragma unroll
                    for (int w = 0; w < 8; ++w) s += red[(w * 5 + bi) * 64 + ln];
                    MOD[((size_t)l * 5 + bi) * 6144 + (it % 96) * 64 + ln] = s; }
                __syncthreads();
            }
        }
        for (int i = gw * 64 + lane; i < MCTX * D / 4; i += NGW * 64) ((f32x4*)XC)[i] = ((const f32x4*)ctx_in)[i];
        for (int i = gw * 64 + lane; i < SEQ * 32; i += NGW * 64) { const int t = i >> 5, p = i & 31; const float pos = (p < 16) ? (float)(t >> 6) : (float)(t & 63);
            const float inv = powf(10000.0f, -(float)(p & 15) / 16.0f); const float ang = pos * inv; COS[i] = cosf(ang); SIN[i] = sinf(ang); }
        for (int i = gw * 64 + lane; i < DEPTH * 8 * 15 * 4 * 1024; i += NGW * 64) {
            const int r = ((i >> 8) & 3) * 4 + (i & 3), ln = (i >> 2) & 63, kb = (i >> 10) & 1, qb = (i >> 11) & 1; const int rest = i >> 12; const int drow = rest % 15, lh = rest / 15;
            const int q32 = ln & 31, hh = ln >> 5; const int koff = 16 * (r >> 3) + 8 * hh + (r & 7); const int kc = kb * 32 + koff, c = qb * 32 + q32;
            const int c0 = min(max(c - 8, 0), 48); const bool ok = (kc >= c0) && (kc < c0 + 16);
            CT[i] = ok ? na_rpb[((size_t)lh * 15 + drow) * 31 + (kc - c + 15)] * LOG2E : NEGBIG;
        }
    }
    SEAM(0);

    for (int l = 0; l < DEPTH; ++l) {
        const int P = 1 + 8 * l;
        const bool lastl = (l == DEPTH - 1);
        const float* modl = MOD + (size_t)l * 5 * 6144;
        const bf16_t* wl = WB + (size_t)l * W_LAYER_ELEMS;
        const float* xlat = (l == 0) ? x_in : out;
        const float* xctx = XC;
        if (IN(P + 0)) {
            PHASE_IDS();
            const int npart1 = (l == 0 || !CTX_SPLITK) ? 0 : 11;
            for (int rep_ = 0; rep_ < ((PROBE_DUP & 1) ? 2 : 1); ++rep_)
            for (int row = gw; row < (rep_ ? MLAT : MT); row += NGW) {
                const bool latent = row < MLAT; const float* xr = latent ? xlat + (size_t)row * D : xctx + (size_t)(row - MLAT) * D;
                const float* mv = modl + (latent ? (row >> 13) : 4) * 6144; const float* gp = norm1_g + l * D;
                f32x4 v[4]; float ss = 0.f;
#pragma unroll
                for (int j = 0; j < 4; ++j) v[j] = *(const f32x4*)(xr + 256 * j + 4 * lane);
                if (!latent && npart1 > 0) { const float* pp = (const float*)(ws + WS_SCR) + (size_t)(row - MLAT) * D + 4 * lane;
                    for (int ch = 0; ch < npart1; ++ch)
#pragma unroll
                        for (int j = 0; j < 4; ++j) v[j] += *(const f32x4*)(pp + (size_t)ch * MCTX * D + 256 * j);
#pragma unroll
                    for (int j = 0; j < 4; ++j) *(f32x4*)(XC + (size_t)(row - MLAT) * D + 256 * j + 4 * lane) = v[j]; }
#pragma unroll
                for (int j = 0; j < 4; ++j) { ss += (v[j][0] * v[j][0] + v[j][1] * v[j][1]) + (v[j][2] * v[j][2] + v[j][3] * v[j][3]); }
                const float rinv = 1.0f / sqrtf(wave_sum(ss) * (1.0f / D) + NORM_EPS);
#pragma unroll
                for (int j = 0; j < 4; ++j) { const int c = 256 * j + 4 * lane; const f32x4 g = *(const f32x4*)(gp + c), sh = *(const f32x4*)(mv + c), sc = *(const f32x4*)(mv + 1024 + c);
                    const f32x4 y = (v[j] * rinv * g) * (1.0f + sc) + sh; u32x2 w; w.x = cvt_pk_bf16(y[0], y[1]); w.y = cvt_pk_bf16(y[2], y[3]); *(u32x2*)(H + (size_t)row * D + c) = w; }
            }
        }
        SEAM(P + 0);
        if (IN(P + 1)) {
            pg8::G1Sched S{(const char*)H, (const char*)(wl + WO_W1), NPAN, G, bx, (lastl || !CTX_GATES) ? 0 : 48};
            pg8::EpiG1 E{ws, b_gate + (size_t)l * 3072};
            pg8::gemm_phase<pg8::EpiG1, pg8::G1Sched>(lds + RING_OFF, S, E);
            if (PROBE_DUP & (1 << 1)) pg8::gemm_phase<pg8::EpiG1, pg8::G1Sched>(lds + RING_OFF, S, E);
        }
        SEAM(P + 1);
        if (IN(P + 2)) {
            PHASE_IDS();
            AttnPtrs AP{QA, KA, VAT, QB, KB, VBT, CT, sw_sink};
            if (PROBE_DUP & (1 << 2)) {
                bf16_t* dump = (bf16_t*)(ws + WS_SCR);
                for (int t = gw; t < NBATCH * 8 * 256; t += NGW) { const int bh = t >> 8, r = (t >> 1) & 127, half = t & 1; na_task(AP, l, bh >> 3, bh & 7, r, half, lane, dump); }
                for (int t = gw; t < NBATCH * 8 * 256; t += NGW) { const int bh = t >> 8, qblk = t & 255; swa_task(AP, l, bh >> 3, bh & 7, qblk, lane, dump); }
                if (!lastl) for (int t = gw; t < 2 * NBATCH * 8 * 8; t += NGW) { const int typ = t >> 8, bh = (t >> 3) & 31, qblk = t & 7; ctx_task(AP, l, typ, bh >> 3, bh & 7, qblk, lane, dump); }
            }
            for (int t = gw; t < NBATCH * 8 * 256; t += NGW) { const int bh = t >> 8, r = (t >> 1) & 127, half = t & 1; na_task(AP, l, bh >> 3, bh & 7, r, half, lane, nullptr); }
            for (int t = gw; t < NBATCH * 8 * 256; t += NGW) { const int bh = t >> 8, qblk = t & 255; swa_task(AP, l, bh >> 3, bh & 7, qblk, lane, nullptr); }
            if (!lastl) for (int t = gw; t < 2 * NBATCH * 8 * 8; t += NGW) { const int typ = t >> 8, bh = (t >> 3) & 31, qblk = t & 7; ctx_task(AP, l, typ, bh >> 3, bh & 7, qblk, lane, nullptr); }
            const int nrows = lastl ? MLAT : MT;
            const float* cw = conv_w + (size_t)l * 3 * 512;
            for (int it = gw * 64 + lane; it < nrows * 64; it += NGW * 64) {
                const int row = it >> 6, ch = (it & 63) * 8;
                const bool latent = row < MLAT; const int tl = latent ? (row & (SEQ - 1)) : ((row - MLAT) & (CTXL - 1)); const int tmax = latent ? SEQ - 1 : CTXL - 1;
                const u32x4 zero = {0u, 0u, 0u, 0u};
                const u32x4 um = (tl > 0) ? *(const u32x4*)(U + (size_t)(row - 1) * 512 + ch) : zero;
                const u32x4 uc = *(const u32x4*)(U + (size_t)row * 512 + ch);
                const u32x4 up = (tl < tmax) ? *(const u32x4*)(U + (size_t)(row + 1) * 512 + ch) : zero;
                const u32x4 gb = *(const u32x4*)(CGB + (size_t)row * 512 + ch);
                f32x4 m0, m1, c0, c1, p0, p1, g0, g1; unpack8(um, m0, m1); unpack8(uc, c0, c1); unpack8(up, p0, p1); unpack8(gb, g0, g1);
                const f32x4 w00 = *(const f32x4*)(cw + ch), w01 = *(const f32x4*)(cw + ch + 4), w10 = *(const f32x4*)(cw + 512 + ch), w11 = *(const f32x4*)(cw + 512 + ch + 4), w20 = *(const f32x4*)(cw + 1024 + ch), w21 = *(const f32x4*)(cw + 1024 + ch + 4);
                const f32x4 y0 = g0 * (w00 * m0 + w10 * c0 + w20 * p0), y1 = g1 * (w01 * m1 + w11 * c1 + w21 * p1);
                *(u32x4*)(CGB + (size_t)row * 512 + ch) = pack8(y0, y1);
            }
        }
        SEAM(P + 2);
        const int nMl = lastl ? NPAN_LAT : NPAN;
        if (IN(P + 3)) {
            pg8::G2Sched S{(const char*)H, (const char*)(wl + WO_W1), (const char*)QA, (const char*)(wl + WO_WBR), nMl, G, bx};
            pg8::EpiG2 E{ws, ws + WS_SCR + (size_t)bx * 262144, b_gate + (size_t)l * 3072};
            pg8::gemm_phase<pg8::EpiG2, pg8::G2Sched>(lds + RING_OFF, S, E);
            if (PROBE_DUP & (1 << 3)) pg8::gemm_phase<pg8::EpiG2, pg8::G2Sched>(lds + RING_OFF, S, E);
        }
        SEAM(P + 3);
        if (IN(P + 4)) {
            pg8::ResSched S{(const char*)MERGED, (const char*)(wl + WO_WO), 2048, 16, 4, lastl ? 0 : 16, G, bx};
            pg8::EpiRes E{xlat, out, XC, (float*)(ws + WS_SCR), modl, 2048};
            pg8::gemm_phase<pg8::EpiRes, pg8::ResSched>(lds + RING_OFF, S, E);
        }
        SEAM(P + 4);
        if (IN(P + 5)) {
            PHASE_IDS();
            const int nrows = lastl ? MLAT : MT;
            for (int rep_ = 0; rep_ < ((PROBE_DUP & 32) ? 2 : 1); ++rep_)
            for (int row = gw; row < (rep_ ? MLAT : nrows); row += NGW) {
                const bool latent = row < MLAT; const float* xr = latent ? out + (size_t)row * D : XC + (size_t)(row - MLAT) * D;
                const float* mv = modl + (latent ? (row >> 13) : 4) * 6144 + 3072; const float* gp = norm2_g + l * D;
                f32x4 v[4]; float ss = 0.f;
#pragma unroll
                for (int j = 0; j < 4; ++j) v[j] = *(const f32x4*)(xr + 256 * j + 4 * lane);
                if (!latent && CTX_SPLITK) { const float* pp = (const float*)(ws + WS_SCR) + (size_t)(row - MLAT) * D + 4 * lane;
                    for (int ch = 0; ch < 4; ++ch)
#pragma unroll
                        for (int j = 0; j < 4; ++j) v[j] += *(const f32x4*)(pp + (size_t)ch * MCTX * D + 256 * j);
#pragma unroll
                    for (int j = 0; j < 4; ++j) *(f32x4*)(XC + (size_t)(row - MLAT) * D + 256 * j + 4 * lane) = v[j]; }
#pragma unroll
                for (int j = 0; j < 4; ++j) { ss += (v[j][0] * v[j][0] + v[j][1] * v[j][1]) + (v[j][2] * v[j][2] + v[j][3] * v[j][3]); }
                const float rinv = 1.0f / sqrtf(wave_sum(ss) * (1.0f / D) + NORM_EPS);
#pragma unroll
                for (int j = 0; j < 4; ++j) { const int c = 256 * j + 4 * lane; const f32x4 g = *(const f32x4*)(gp + c), sh = *(const f32x4*)(mv + c), sc = *(const f32x4*)(mv + 1024 + c);
                    const f32x4 y = (v[j] * rinv * g) * (1.0f + sc) + sh; u32x2 w; w.x = cvt_pk_bf16(y[0], y[1]); w.y = cvt_pk_bf16(y[2], y[3]); *(u32x2*)(H + (size_t)row * D + c) = w; }
            }
        }
        SEAM(P + 5);
        if (IN(P + 6)) {
            pg8::SimpleSched S{(const char*)H, (const char*)(wl + WO_W4), 2048, 2048, 16, nMl, 22, G, bx};
            pg8::EpiSwiglu E{ACT};
            pg8::gemm_phase<pg8::EpiSwiglu, pg8::SimpleSched>(lds + RING_OFF, S, E);
            if (PROBE_DUP & (1 << 6)) pg8::gemm_phase<pg8::EpiSwiglu, pg8::SimpleSched>(lds + RING_OFF, S, E);
        }
        SEAM(P + 6);
        if (IN(P + 7)) {
            pg8::ResSched S{(const char*)ACT, (const char*)(wl + WO_W5), 2 * DFF, DFF / 64, 11, lastl ? 0 : 16, G, bx};
            pg8::EpiRes E{out, out, XC, (float*)(ws + WS_SCR), modl, 5120};
            pg8::gemm_phase<pg8::EpiRes, pg8::ResSched>(lds + RING_OFF, S, E);
        }
        SEAM(P + 7);
    }
    if (IN(NPHASE - 1)) {
        PHASE_IDS();
        for (int row = gw; row < MLAT; row += NGW) {
            float* xr = out + (size_t)row * D;
            f32x4 v[4]; float ss = 0.f;
#pragma unroll
            for (int j = 0; j < 4; ++j) { v[j] = *(const f32x4*)(xr + 256 * j + 4 * lane); ss += (v[j][0] * v[j][0] + v[j][1] * v[j][1]) + (v[j][2] * v[j][2] + v[j][3] * v[j][3]); }
            const float rinv = 1.0f / sqrtf(wave_sum(ss) * (1.0f / D) + NORM_EPS);
#pragma unroll
            for (int j = 0; j < 4; ++j) { const int c = 256 * j + 4 * lane; const f32x4 g = *(const f32x4*)(final_g + c); *(f32x4*)(xr + c) = v[j] * rinv * g; }
        }
    }
#undef IN
#undef SEAM
}

extern "C" void kernel_launch(void* const* d_in, const int* in_sizes, int n_in, void* d_out, int out_size, void* d_ws, size_t ws_size, hipStream_t stream) {
    static int grid = 0;
    if (grid == 0) {
        if (n_in != 20 || in_sizes[0] != MLAT * D || out_size != MLAT * D || ws_size < WS_END) {
            fprintf(stderr, "kernel_launch: unexpected shapes: n_in %d in0 %d out %d ws %zu (need %zu); nothing launched\n", n_in, n_in > 0 ? in_sizes[0] : -1, out_size, ws_size, (size_t)WS_END); grid = -1; return; }
        int dev = 0, cus = 0, per_cu = 0;
        if (hipGetDevice(&dev) != hipSuccess || hipDeviceGetAttribute(&cus, hipDeviceAttributeMultiprocessorCount, dev) != hipSuccess) { fprintf(stderr, "kernel_launch: device query failed\n"); grid = -1; return; }
        if (hipFuncSetAttribute((const void*)fwd_kernel, hipFuncAttributeMaxDynamicSharedMemorySize, LDS_BYTES) != hipSuccess) { fprintf(stderr, "kernel_launch: hipFuncSetAttribute failed\n"); grid = -1; return; }
        if (hipOccupancyMaxActiveBlocksPerMultiprocessor(&per_cu, (const void*)fwd_kernel, NWAVES * 64, LDS_BYTES) != hipSuccess || per_cu < 1)
            fprintf(stderr, "kernel_launch: note: occupancy query reports %d workgroups per CU\n", per_cu);
        (void)hipGetLastError();
        grid = cus > 256 ? 256 : cus;
    }
    if (grid < 0) return;
    if (hipMemsetAsync((char*)d_ws + WS_CTL, 0, CTL_ZERO_BYTES, stream) != hipSuccess) { fprintf(stderr, "kernel_launch: memset failed\n"); return; }
    Args a{};
    for (int i = 0; i < 20; ++i) a.in[i] = (const float*)d_in[i];
    a.out = (float*)d_out; a.ws = (unsigned char*)d_ws;
#if MK_SINGLE
    a.ph_lo = 0; a.ph_hi = NPHASE;
    hipLaunchKernelGGL(fwd_kernel, dim3(grid), dim3(NWAVES * 64), LDS_BYTES, stream, a);
#else
    for (int p = 0; p < NPHASE; ++p) { a.ph_lo = p; a.ph_hi = p + 1; hipLaunchKernelGGL(fwd_kernel, dim3(grid), dim3(NWAVES * 64), LDS_BYTES, stream, a); }
#endif
    const hipError_t le = hipPeekAtLastError();
    if (le != hipSuccess) fprintf(stderr, "kernel_launch: launch failed: %s\n", hipGetErrorName(le));
}
```
